# Optimizing an MI355X kernel written in HIP

```python
import math
import jax, jax.numpy as jnp
from jax import lax
import numpy as np

D_MODEL = 2048
BATCH = 4
SEQ = 2048
DEPTH = 4
DEC_BATCH = 128
DEC_SEQ = 8
PAST_LEN = 16384
PAGE_SIZE = 128

N_EVEN = (DEPTH + 1) // 2
N_ODD = DEPTH // 2
D_POOL = D_MODEL // 2
POOL_WINDOWS = (2, 4, 8, 16)
N_POOL_GROUPS = len(POOL_WINDOWS)
POOL_GROUP = D_POOL // N_POOL_GROUPS
POOL_BUF = max(POOL_WINDOWS) - 1
D_RNN = D_MODEL // 2
RNN_HEADS = 8
RNN_HEAD_DIM = D_RNN // RNN_HEADS
CONV_W = 4
RG_C = 8.0
D_IN_EVEN = D_POOL + 2 * D_RNN
SSM_GROUP = 16
SSM_GROUPS = D_MODEL // SSM_GROUP
SSM_STATE = 64
SCAN_BLOCK = 128
D_FF = ((8 * D_MODEL // 3 + 127) // 128) * 128
RMS_EPS = 1e-6

kernel_name = "hybrid_pool_rglru_s5_macaron_step"


def rmsnorm(x, g):
    xf = x.astype(jnp.float32)
    y = xf * lax.rsqrt(jnp.mean(xf * xf, axis=-1, keepdims=True) + RMS_EPS)
    return (y * g.astype(jnp.float32)).astype(x.dtype)


def swiglu(x, w_in, w_out):
    gu = x @ w_in
    return (jax.nn.silu(gu[..., :D_FF]) * gu[..., D_FF:]) @ w_out


def pool_mixer(u, buf, pos0, w_grp, scale):
    bsz, L, _ = u.shape
    full = jnp.concatenate([buf, u], axis=1).astype(jnp.float32)
    cs = jnp.pad(jnp.cumsum(full, axis=1), ((0, 0), (1, 0), (0, 0)))
    pos = pos0 + jnp.arange(L)
    end = cs[:, POOL_BUF + 1:]
    means = []
    for g, w in enumerate(POOL_WINDOWS):
        sl = slice(g * POOL_GROUP, (g + 1) * POOL_GROUP)
        start = cs[:, POOL_BUF + 1 - w:POOL_BUF + 1 - w + L, sl]
        cnt = jnp.minimum(pos + 1, w).astype(jnp.float32)[None, :, None]
        means.append((end[..., sl] - start) / cnt)
    diff = (jnp.concatenate(means, axis=-1) - full[:, POOL_BUF:]).astype(u.dtype)
    diff = diff.reshape(bsz, L, N_POOL_GROUPS, POOL_GROUP)
    out = jnp.einsum('blgc,gcd->blgd', diff, w_grp).reshape(bsz, L, D_POOL) * scale
    return out, full[:, -POOL_BUF:].astype(u.dtype)


def causal_depthwise_conv(v, buf, w, b):
    full = jnp.concatenate([buf, v], axis=1)
    y = lax.conv_general_dilated(full, w[:, None, :], window_strides=(1,), padding='VALID',
                                 dimension_numbers=('NWC', 'WIO', 'NWC'),
                                 feature_group_count=v.shape[-1])
    return y + b, full[:, -(CONV_W - 1):]


def block_diag_linear(x, w, b):
    bsz, L, _ = x.shape
    xh = x.reshape(bsz, L, RNN_HEADS, RNN_HEAD_DIM)
    return jnp.einsum('blhi,hij->blhj', xh, w).reshape(bsz, L, D_RNN) + b


def rglru(x, h0, pos0, w_a, b_a, w_x, b_x, lam):
    L = x.shape[1]
    f32 = jnp.float32
    r = jax.nn.sigmoid(block_diag_linear(x, w_a, b_a).astype(f32))
    i = jax.nn.sigmoid(block_diag_linear(x, w_x, b_x).astype(f32))
    log_a = RG_C * r * jax.nn.log_sigmoid(lam.astype(f32))
    reset = (pos0 + jnp.arange(L) == 0)[None, :, None]
    a = jnp.where(reset, 0.0, jnp.exp(log_a))
    mult = jnp.where(reset, 1.0, jnp.sqrt(-jnp.expm1(2.0 * log_a)))
    b = mult * i * x.astype(f32)
    b = b.at[:, 0].add(a[:, 0] * h0.astype(f32))

    def combine(l, rr):
        return (l[0] * rr[0], rr[0] * l[1] + rr[1])

    _, h = lax.associative_scan(combine, (a, b), axis=1)
    return h, h[:, -1]


def even_mixer(hn, pool_buf, conv_buf, h0, pos0, w_in, pool_w, pool_scale, conv_w, conv_b,
               gate_a_w, gate_a_b, gate_x_w, gate_x_b, lam, w_out):
    z = hn @ w_in
    u_pool = z[..., :D_POOL]
    u_rnn = z[..., D_POOL:D_POOL + D_RNN]
    u_gate = z[..., D_POOL + D_RNN:]
    pool_out, new_pool = pool_mixer(u_pool, pool_buf, pos0, pool_w, pool_scale)
    conv_out, new_conv = causal_depthwise_conv(u_rnn, conv_buf, conv_w, conv_b)
    rec, new_h = rglru(conv_out, h0, pos0, gate_a_w, gate_a_b, gate_x_w, gate_x_b, lam)
    rnn_out = rec.astype(hn.dtype) * jax.nn.gelu(u_gate)
    y = jnp.concatenate([pool_out, rnn_out], axis=-1) @ w_out
    return y, new_pool, new_conv, new_h.astype(hn.dtype)


def complex_combine(l, r):
    a1r, a1i, b1r, b1i = l
    a2r, a2i, b2r, b2i = r
    return (a2r * a1r - a2i * a1i, a2r * a1i + a2i * a1r,
            a2r * b1r - a2i * b1i + b2r, a2r * b1i + a2i * b1r + b2i)


def s5_mixer(u, s_re, s_im, lam_re, lam_im, log_step, b_re, b_im, c_re, c_im, d, w_glu):
    bsz, L, _ = u.shape
    f32 = jnp.float32
    lr = jnp.minimum(lam_re.astype(f32), -1e-4)
    li = lam_im.astype(f32)
    dt = jnp.exp(log_step.astype(f32))[:, None]
    mag = jnp.exp(lr * dt)
    ab_re = mag * jnp.cos(li * dt)
    ab_im = mag * jnp.sin(li * dt)
    den = lr * lr + li * li
    nr = ab_re - 1.0
    f_re = (nr * lr + ab_im * li) / den
    f_im = (ab_im * lr - nr * li) / den
    br = b_re.astype(f32)
    bi = b_im.astype(f32)
    bb_re = f_re[..., None] * br - f_im[..., None] * bi
    bb_im = f_re[..., None] * bi + f_im[..., None] * br
    cr = c_re.astype(f32)
    ci = c_im.astype(f32)
    dg = d.astype(f32).reshape(SSM_GROUPS, SSM_GROUP)
    blk = math.gcd(L, SCAN_BLOCK)
    n_blk = L // blk
    ub = u.astype(f32).reshape(bsz, n_blk, blk, SSM_GROUPS, SSM_GROUP).transpose(1, 2, 0, 3, 4)
    a_re = jnp.broadcast_to(ab_re, (blk, bsz, SSM_GROUPS, SSM_STATE))
    a_im = jnp.broadcast_to(ab_im, (blk, bsz, SSM_GROUPS, SSM_STATE))

    def step(carry, ublk):
        xr0, xi0 = carry
        bu_re = jnp.einsum('tbgc,gpc->tbgp', ublk, bb_re)
        bu_im = jnp.einsum('tbgc,gpc->tbgp', ublk, bb_im)
        bu_re = bu_re.at[0].add(ab_re * xr0 - ab_im * xi0)
        bu_im = bu_im.at[0].add(ab_re * xi0 + ab_im * xr0)
        _, _, xr, xi = lax.associative_scan(complex_combine, (a_re, a_im, bu_re, bu_im), axis=0)
        y = (jnp.einsum('tbgp,gcp->tbgc', xr, cr) - jnp.einsum('tbgp,gcp->tbgc', xi, ci)
             + dg * ublk)
        return (xr[-1], xi[-1]), y

    (sr, si), yb = lax.scan(step, (s_re.astype(f32), s_im.astype(f32)), ub)
    y = yb.transpose(2, 0, 1, 3, 4).reshape(bsz, L, D_MODEL)
    z = jax.nn.gelu(y).astype(u.dtype) @ w_glu
    out = z[..., :D_MODEL] * jax.nn.sigmoid(z[..., D_MODEL:])
    return out, sr.astype(u.dtype), si.astype(u.dtype)


def trunk(x, st_pool, st_conv, st_h, st_re, st_im, pos0, p):
    new_pool, new_conv, new_h, new_re, new_im = [], [], [], [], []
    for layer in range(DEPTH):
        x = x + 0.5 * swiglu(rmsnorm(x, p['norm_ffn1'][layer]), p['w_ffn1_in'][layer], p['w_ffn1_out'][layer])
        hn = rmsnorm(x, p['norm_mix'][layer])
        if layer % 2 == 0:
            e = layer // 2
            y, pb, cb, hh = even_mixer(hn, st_pool[e], st_conv[e], st_h[e], pos0,
                                       p['w_in_even'][e], p['pool_w'][e], p['pool_scale'][e],
                                       p['conv_w'][e], p['conv_b'][e], p['gate_a_w'][e], p['gate_a_b'][e],
                                       p['gate_x_w'][e], p['gate_x_b'][e], p['rglru_lambda'][e],
                                       p['w_out_even'][e])
            new_pool.append(pb)
            new_conv.append(cb)
            new_h.append(hh)
        else:
            o = layer // 2
            y, sr, si = s5_mixer(hn, st_re[o], st_im[o], p['ssm_lambda_re'][o], p['ssm_lambda_im'][o],
                                 p['ssm_log_step'][o], p['ssm_b_re'][o], p['ssm_b_im'][o],
                                 p['ssm_c_re'][o], p['ssm_c_im'][o], p['ssm_d'][o], p['w_glu'][o])
            new_re.append(sr)
            new_im.append(si)
        x = x + y
        x = x + 0.5 * swiglu(rmsnorm(x, p['norm_ffn2'][layer]), p['w_ffn2_in'][layer], p['w_ffn2_out'][layer])
    return (rmsnorm(x, p['final_norm']), jnp.stack(new_pool), jnp.stack(new_conv), jnp.stack(new_h),
            jnp.stack(new_re), jnp.stack(new_im))


def setup_inputs(seed: int = 0) -> dict:
    key = jax.random.key(seed)
    ks = iter(jax.random.split(key, 40))
    f32 = jnp.float32

    def nrm(shape, s):
        return jax.random.normal(next(ks), shape, f32) * s

    rad = jnp.sqrt(jax.random.uniform(next(ks), (N_EVEN, D_RNN), f32, 0.81, 0.998))
    lam_im0 = jnp.broadcast_to(math.pi * jnp.arange(SSM_STATE, dtype=f32), (N_ODD, SSM_GROUPS, SSM_STATE))
    return {
        "x_prompt": nrm((BATCH, SEQ, D_MODEL), 1.0),
        "x_sample": nrm((DEC_BATCH, DEC_SEQ, D_MODEL), 1.0),
        "state_pool": nrm((N_EVEN, DEC_BATCH, POOL_BUF, D_POOL), 1.0),
        "state_conv": nrm((N_EVEN, DEC_BATCH, CONV_W - 1, D_RNN), 1.0),
        "state_rglru": nrm((N_EVEN, DEC_BATCH, D_RNN), 0.5),
        "state_ssm_re": nrm((N_ODD, DEC_BATCH, SSM_GROUPS, SSM_STATE), 0.1),
        "state_ssm_im": nrm((N_ODD, DEC_BATCH, SSM_GROUPS, SSM_STATE), 0.1),
        "norm_ffn1": 1.0 + nrm((DEPTH, D_MODEL), 0.02),
        "w_ffn1_in": nrm((DEPTH, D_MODEL, 2 * D_FF), D_MODEL ** -0.5),
        "w_ffn1_out": nrm((DEPTH, D_FF, D_MODEL), D_FF ** -0.5),
        "norm_mix": 1.0 + nrm((DEPTH, D_MODEL), 0.02),
        "norm_ffn2": 1.0 + nrm((DEPTH, D_MODEL), 0.02),
        "w_ffn2_in": nrm((DEPTH, D_MODEL, 2 * D_FF), D_MODEL ** -0.5),
        "w_ffn2_out": nrm((DEPTH, D_FF, D_MODEL), D_FF ** -0.5),
        "w_in_even": nrm((N_EVEN, D_MODEL, D_IN_EVEN), D_MODEL ** -0.5),
        "pool_w": nrm((N_EVEN, N_POOL_GROUPS, POOL_GROUP, POOL_GROUP), POOL_GROUP ** -0.5),
        "pool_scale": 1.0 + nrm((N_EVEN, D_POOL), 0.02),
        "conv_w": nrm((N_EVEN, CONV_W, D_RNN), CONV_W ** -0.5),
        "conv_b": nrm((N_EVEN, D_RNN), 0.01),
        "gate_a_w": nrm((N_EVEN, RNN_HEADS, RNN_HEAD_DIM, RNN_HEAD_DIM), RNN_HEAD_DIM ** -0.5),
        "gate_a_b": nrm((N_EVEN, D_RNN), 0.01),
        "gate_x_w": nrm((N_EVEN, RNN_HEADS, RNN_HEAD_DIM, RNN_HEAD_DIM), RNN_HEAD_DIM ** -0.5),
        "gate_x_b": nrm((N_EVEN, D_RNN), 0.01),
        "rglru_lambda": jnp.log(rad) - jnp.log1p(-rad),
        "w_out_even": nrm((N_EVEN, D_POOL + D_RNN, D_MODEL), (D_POOL + D_RNN) ** -0.5),
        "ssm_lambda_re": -0.5 + nrm((N_ODD, SSM_GROUPS, SSM_STATE), 0.01),
        "ssm_lambda_im": lam_im0 + nrm((N_ODD, SSM_GROUPS, SSM_STATE), 0.01),
        "ssm_log_step": jax.random.uniform(next(ks), (N_ODD, SSM_GROUPS), f32, math.log(1e-3), math.log(1e-1)),
        "ssm_b_re": nrm((N_ODD, SSM_GROUPS, SSM_STATE, SSM_GROUP), (2 * SSM_GROUP) ** -0.5),
        "ssm_b_im": nrm((N_ODD, SSM_GROUPS, SSM_STATE, SSM_GROUP), (2 * SSM_GROUP) ** -0.5),
        "ssm_c_re": nrm((N_ODD, SSM_GROUPS, SSM_GROUP, SSM_STATE), SSM_STATE ** -0.5),
        "ssm_c_im": nrm((N_ODD, SSM_GROUPS, SSM_GROUP, SSM_STATE), SSM_STATE ** -0.5),
        "ssm_d": nrm((N_ODD, D_MODEL), 1.0),
        "w_glu": nrm((N_ODD, D_MODEL, 2 * D_MODEL), D_MODEL ** -0.5),
        "final_norm": 1.0 + nrm((D_MODEL,), 0.02),
    }


def reference(x_prompt, x_sample, state_pool, state_conv, state_rglru, state_ssm_re, state_ssm_im,
              norm_ffn1, w_ffn1_in, w_ffn1_out, norm_mix, norm_ffn2, w_ffn2_in, w_ffn2_out,
              w_in_even, pool_w, pool_scale, conv_w, conv_b, gate_a_w, gate_a_b, gate_x_w, gate_x_b,
              rglru_lambda, w_out_even, ssm_lambda_re, ssm_lambda_im, ssm_log_step, ssm_b_re, ssm_b_im,
              ssm_c_re, ssm_c_im, ssm_d, w_glu, final_norm):
    p = dict(norm_ffn1=norm_ffn1, w_ffn1_in=w_ffn1_in, w_ffn1_out=w_ffn1_out, norm_mix=norm_mix,
             norm_ffn2=norm_ffn2, w_ffn2_in=w_ffn2_in, w_ffn2_out=w_ffn2_out, w_in_even=w_in_even,
             pool_w=pool_w, pool_scale=pool_scale, conv_w=conv_w, conv_b=conv_b, gate_a_w=gate_a_w,
             gate_a_b=gate_a_b, gate_x_w=gate_x_w, gate_x_b=gate_x_b, rglru_lambda=rglru_lambda,
             w_out_even=w_out_even, ssm_lambda_re=ssm_lambda_re, ssm_lambda_im=ssm_lambda_im,
             ssm_log_step=ssm_log_step, ssm_b_re=ssm_b_re, ssm_b_im=ssm_b_im, ssm_c_re=ssm_c_re,
             ssm_c_im=ssm_c_im, ssm_d=ssm_d, w_glu=w_glu, final_norm=final_norm)
    dt = x_prompt.dtype
    y_prompt, pool_p, conv_p, h_p, re_p, im_p = trunk(
        x_prompt,
        jnp.zeros((N_EVEN, BATCH, POOL_BUF, D_POOL), dt),
        jnp.zeros((N_EVEN, BATCH, CONV_W - 1, D_RNN), dt),
        jnp.zeros((N_EVEN, BATCH, D_RNN), dt),
        jnp.zeros((N_ODD, BATCH, SSM_GROUPS, SSM_STATE), dt),
        jnp.zeros((N_ODD, BATCH, SSM_GROUPS, SSM_STATE), dt),
        0, p)
    y_sample, pool_s, conv_s, h_s, re_s, im_s = trunk(
        x_sample, state_pool, state_conv, state_rglru, state_ssm_re, state_ssm_im, PAST_LEN, p)
    return (y_prompt, y_sample, pool_p, pool_s, conv_p, conv_s, h_p, h_s, re_p, re_s, im_p, im_s)
```

```cpp
#include <hip/hip_runtime.h>
#include <cstdio>
#include <cstdint>
#include <cstring>
namespace pg8 {
#define PG8_LAS __attribute__((address_space(3)))
typedef unsigned short bf16_t;
typedef short bf16x8 __attribute__((ext_vector_type(8)));
typedef float f32x4 __attribute__((ext_vector_type(4)));
typedef unsigned u32x4 __attribute__((ext_vector_type(4)));
constexpr int BM = 256, BK = 64, HALF = 128, HTB = HALF * BK * 2  , STAGE_BYTES = 8 * HTB, NXCD = 8, WGM = 8;

__host__ __device__ __forceinline__ int lds_byte(int r, int c) { const int st = (r >> 4) * 2 + (c >> 5), rr = r & 15, cc = c & 31, ob = rr * 64 + cc * 2; return st * 1024 + (ob ^ (((ob >> 9) & 1) << 5)); }
__host__ __device__ __forceinline__ void stage_rc(int b, int& R, int& C) { const int st = b / 1024, sb = b % 1024, swz = sb ^ (((sb >> 9) & 1) << 5); R = (st >> 1) * 16 + swz / 64; C = (st & 1) * 32 + (swz % 64) / 2; }
__host__ __device__ __forceinline__ int perm32(int rho) { const int n = rho >> 4, i = rho & 15; return 8 * (i >> 2) + 4 * n + (i & 3); }

struct Unit { int pm, pn, ka, kb, nt, aux; };
struct Gemm { const bf16_t* A; const bf16_t* Bt; int M, N, K, lda, ak_shift, ak_mul; };

struct StaticOrder {
    int nM, nN, nwg, G, c, imax, K, ak_shift, ak_mul;
    __host__ __device__ void init(const Gemm& g, int G_, int c_, int imax_ = 1 << 30) { nM = g.M / BM; nN = g.N / BM; nwg = nM * nN; G = G_; c = c_; imax = imax_; K = g.K; ak_shift = g.ak_shift; ak_mul = g.ak_mul; }
    __host__ __device__ void tile_of(int L, Unit& u) const {
        int wgid = L; { const int q = nwg / NXCD, r = nwg % NXCD, xcd = wgid % NXCD, off = wgid / NXCD; wgid = (xcd < r ? xcd * (q + 1) : r * (q + 1) + (xcd - r) * q) + off; }
        const int nig = WGM * nN, gid = wgid / nig, fm = gid * WGM, gsz = (nM - fm) < WGM ? (nM - fm) : WGM;
        u.pm = fm + ((wgid % nig) % gsz); u.pn = (wgid % nig) / gsz; }
    __host__ __device__ bool next(int i, Unit& u) const {
        const long L = (long)i * G + c; if (L >= nwg || i >= imax) return false;
        tile_of((int)L, u); u.ka = (u.pn >> ak_shift) * ak_mul; u.kb = 0; u.nt = K / BK; u.aux = 0; return true;
    }
    __device__ __forceinline__ void a_ready(const Unit&) const {}
    __device__ __forceinline__ void done(const Unit&) const {}
};
struct SplitTailOrder {
    StaticOrder so; int L0, ntail, nsplit, npairs;
    __host__ __device__ void init(const Gemm& g, int G_, int c_, int L0_, int ntail_, int nsplit_) { so.init(g, G_, c_); L0 = L0_; ntail = ntail_; nsplit = nsplit_; npairs = g.K / (2 * BK); }
    __host__ __device__ bool next(int i, Unit& u) const {
        if (i != 0 || so.c >= ntail * nsplit) return false;
        const int ti = so.c % ntail, s = so.c / ntail, p0 = (s * npairs) / nsplit, p1 = ((s + 1) * npairs) / nsplit;
        so.tile_of(L0 + ti, u); u.ka = p0 * 2 * BK; u.kb = u.ka; u.nt = 2 * (p1 - p0); u.aux = s * ntail + ti; return true;
    }
    __device__ __forceinline__ void a_ready(const Unit&) const {}
    __device__ __forceinline__ void done(const Unit&) const {}
};

struct SeqOrder {
    StaticOrder so, ss; int G, c, i0, i1, npu, nsu, npm, nsm, K; unsigned* flag; unsigned target;
    __host__ __device__ void init(const Gemm& g, int npanels_first, int G_, int c_, int i0_, int i1_) { Gemm gp = g; gp.M = npanels_first * BM; so.init(gp, G_, c_); gp.M = g.M - npanels_first * BM; ss.init(gp, G_, c_); G = G_; c = c_; i0 = i0_; i1 = i1_;
        npm = npanels_first; nsm = g.M / BM - npanels_first; npu = npm * (g.N / BM); nsu = nsm * (g.N / BM); K = g.K; flag = nullptr; target = 0u; }
    __host__ __device__ bool next(int i, Unit& u) const {
        const int ii = i0 + i; if (ii >= i1) return false; const int s = ii * G + c;
        if (s < npu) so.tile_of(s, u); else { const int j = s - npu; if (j >= nsu) return false; ss.tile_of(j, u); u.pm += npm; }
        u.ka = 0; u.kb = 0; u.nt = K / BK; u.aux = 0; return true; }
    __device__ __forceinline__ void a_ready(const Unit& u) const { if (flag != nullptr && u.pm >= npm) { unsigned sp_ = 0u;
            while (__hip_atomic_load(flag, __ATOMIC_RELAXED, __HIP_MEMORY_SCOPE_AGENT) < target) { __builtin_amdgcn_s_sleep(2); if (++sp_ > (1u << 22)) break; }
            __builtin_amdgcn_fence(__ATOMIC_ACQUIRE, "agent"); asm volatile("s_waitcnt vmcnt(0)" ::: "memory"); } }
    __device__ __forceinline__ void done(const Unit&) const {}
};
struct FewUnitsOrder { int pm0, npm, nN, first, cnt, K;
    __host__ __device__ bool next(int i, Unit& u) const { if (i >= cnt) return false; const int t = first + i; u.pm = pm0 + t % npm; u.pn = t / npm; u.ka = 0; u.kb = 0; u.nt = K / BK; u.aux = 0; return true; }
    __device__ __forceinline__ void a_ready(const Unit&) const {}
    __device__ __forceinline__ void done(const Unit&) const {}
};

__device__ __forceinline__ unsigned cvt_pk_bf16(float lo, float hi) { unsigned r; asm volatile("v_cvt_pk_bf16_f32 %0, %1, %2" : "=v"(r) : "v"(lo), "v"(hi)); return r; }
typedef float f32x2 __attribute__((ext_vector_type(2)));
typedef unsigned u32x2 __attribute__((ext_vector_type(2)));
constexpr float RMS_EPS = 1e-6f;
typedef unsigned long long rs_t;
__device__ __forceinline__ void rs_add(rs_t* p, float ss) { atomicAdd(p, (rs_t)(ss * 1048576.0f + 0.5f)); }
__device__ __forceinline__ float rs_get(rs_t v) { return (float)v * (1.0f / 1048576.0f); }
__device__ __forceinline__ float bf_lo(unsigned u) { return __builtin_bit_cast(float, u << 16); }
__device__ __forceinline__ float bf_hi(unsigned u) { return __builtin_bit_cast(float, u & 0xffff0000u); }
__device__ __forceinline__ float sigmoidf_fast(float x) { return __builtin_amdgcn_rcpf(1.0f + __expf(-x)); }
__device__ __forceinline__ float rstd_of(float sumsq, float inv_n) { return __builtin_amdgcn_rsqf(sumsq * inv_n + RMS_EPS); }

struct EpiSwiglu {
    static constexpr bool PERM = true, AFTER_DRAIN = false;
    bf16_t* H; int ldh; const rs_t* rs; float inv_n;
    __device__ __forceinline__ void operator()(const f32x4 (&acc)[2][2][4][2], const Unit& u, int wr, int wc, int fr, int fq) const {
        const int row0 = u.pm * BM + wr * 64 + fr, col0 = u.pn * HALF + wc * 32 + 8 * fq;
#pragma unroll
        for (int ai = 0; ai < 2; ++ai)
#pragma unroll
            for (int m = 0; m < 4; ++m) { const int row = row0 + ai * HALF + m * 16;
                const float ms = rs_get(rs[row]) * inv_n + RMS_EPS, c2 = -1.4426950408889634f * __builtin_amdgcn_rsqf(ms);
                float h[8];
#pragma unroll
                for (int n = 0; n < 2; ++n)
#pragma unroll
                    for (int e = 0; e < 4; ++e) { const float g = acc[ai][0][m][n][e], uu = acc[ai][1][m][n][e]; const float ex = __builtin_amdgcn_exp2f(g * c2); h[4 * n + e] = (g * uu) * __builtin_amdgcn_rcpf(__builtin_fmaf(ex, ms, ms)); }
                u32x4 w; w.x = cvt_pk_bf16(h[0], h[1]); w.y = cvt_pk_bf16(h[2], h[3]); w.z = cvt_pk_bf16(h[4], h[5]); w.w = cvt_pk_bf16(h[6], h[7]);
                *(u32x4*)(H + (size_t)row * ldh + col0) = w; }
    }
};
struct EpiResid {
    static constexpr bool PERM = true, AFTER_DRAIN = false;
    bf16_t* Xb; rs_t* rsn; float alpha;
    __device__ __forceinline__ void operator()(const f32x4 (&acc)[2][2][4][2], const Unit& u, int wr, int wc, int fr, int fq) const {
        const int row0 = u.pm * BM + wr * 64 + fr, col0 = u.pn * BM + wc * 32 + 8 * fq;
#pragma unroll
        for (int ai = 0; ai < 2; ++ai)
#pragma unroll
            for (int m = 0; m < 4; ++m) { const int row = row0 + ai * HALF + m * 16; float ss = 0.f;
#pragma unroll
                for (int bj = 0; bj < 2; ++bj) { const size_t off = (size_t)row * 2048 + col0 + bj * HALF; const u32x4 xo = *(const u32x4*)(Xb + off);
                    const f32x4 a0 = acc[ai][bj][m][0], a1 = acc[ai][bj][m][1];
                    u32x4 w; w.x = cvt_pk_bf16(bf_lo(xo.x) + a0[0] * alpha, bf_hi(xo.x) + a0[1] * alpha); w.y = cvt_pk_bf16(bf_lo(xo.y) + a0[2] * alpha, bf_hi(xo.y) + a0[3] * alpha);
                    w.z = cvt_pk_bf16(bf_lo(xo.z) + a1[0] * alpha, bf_hi(xo.z) + a1[1] * alpha); w.w = cvt_pk_bf16(bf_lo(xo.w) + a1[2] * alpha, bf_hi(xo.w) + a1[3] * alpha);
                    *(u32x4*)(Xb + off) = w;
                    const float v0 = bf_lo(w.x), v1 = bf_hi(w.x), v2 = bf_lo(w.y), v3 = bf_hi(w.y), v4 = bf_lo(w.z), v5 = bf_hi(w.z), v6 = bf_lo(w.w), v7 = bf_hi(w.w);
                    ss += ((v0 * v0 + v1 * v1) + (v2 * v2 + v3 * v3)) + ((v4 * v4 + v5 * v5) + (v6 * v6 + v7 * v7)); }
                ss += __shfl_xor(ss, 16); ss += __shfl_xor(ss, 32);
                if (fq == 0) rs_add(rsn + row, ss); }
    }
};
struct EpiGlu {
    static constexpr bool PERM = true, AFTER_DRAIN = false;
    bf16_t* Xb; rs_t* rsn;
    __device__ __forceinline__ void operator()(const f32x4 (&acc)[2][2][4][2], const Unit& u, int wr, int wc, int fr, int fq) const {
        const int row0 = u.pm * BM + wr * 64 + fr, col0 = u.pn * HALF + wc * 32 + 8 * fq;
#pragma unroll
        for (int ai = 0; ai < 2; ++ai)
#pragma unroll
            for (int m = 0; m < 4; ++m) { const int row = row0 + ai * HALF + m * 16; const size_t off = (size_t)row * 2048 + col0; const u32x4 xo = *(const u32x4*)(Xb + off);
                float v[8] = {bf_lo(xo.x), bf_hi(xo.x), bf_lo(xo.y), bf_hi(xo.y), bf_lo(xo.z), bf_hi(xo.z), bf_lo(xo.w), bf_hi(xo.w)};
#pragma unroll
                for (int n = 0; n < 2; ++n)
#pragma unroll
                    for (int e = 0; e < 4; ++e) v[4 * n + e] += acc[ai][0][m][n][e] * sigmoidf_fast(acc[ai][1][m][n][e]);
                u32x4 w; w.x = cvt_pk_bf16(v[0], v[1]); w.y = cvt_pk_bf16(v[2], v[3]); w.z = cvt_pk_bf16(v[4], v[5]); w.w = cvt_pk_bf16(v[6], v[7]); *(u32x4*)(Xb + off) = w;
                const float v0 = bf_lo(w.x), v1 = bf_hi(w.x), v2 = bf_lo(w.y), v3 = bf_hi(w.y), v4 = bf_lo(w.z), v5 = bf_hi(w.z), v6 = bf_lo(w.w), v7 = bf_hi(w.w);
                float ss = ((v0 * v0 + v1 * v1) + (v2 * v2 + v3 * v3)) + ((v4 * v4 + v5 * v5) + (v6 * v6 + v7 * v7));
                ss += __shfl_xor(ss, 16); ss += __shfl_xor(ss, 32);
                if (fq == 0) rs_add(rsn + row, ss); }
    }
};
struct EpiPartial {
    static constexpr bool PERM = true, AFTER_DRAIN = false;
    bf16_t* P;
    __device__ __forceinline__ void operator()(const f32x4 (&acc)[2][2][4][2], const Unit& u, int wr, int wc, int fr, int fq) const {
        bf16_t* base = P + (size_t)u.aux * (BM * BM) + (size_t)(wr * 64 + fr) * BM + wc * 32 + 8 * fq;
#pragma unroll
        for (int ai = 0; ai < 2; ++ai)
#pragma unroll
            for (int m = 0; m < 4; ++m) { bf16_t* rowp = base + (size_t)(ai * HALF + m * 16) * BM;
#pragma unroll
                for (int bj = 0; bj < 2; ++bj) { const f32x4 v0 = acc[ai][bj][m][0], v1 = acc[ai][bj][m][1];
                    u32x4 w; w.x = cvt_pk_bf16(v0[0], v0[1]); w.y = cvt_pk_bf16(v0[2], v0[3]); w.z = cvt_pk_bf16(v1[0], v1[1]); w.w = cvt_pk_bf16(v1[2], v1[3]); *(u32x4*)(rowp + bj * HALF) = w; } }
    }
};
struct EpiZ {
    static constexpr bool PERM = true, AFTER_DRAIN = false;
    bf16_t* Z; int ldz; const rs_t* rs; float inv_n; bf16_t* UGb; int Mrows;
    __device__ __forceinline__ void operator()(const f32x4 (&acc)[2][2][4][2], const Unit& u, int wr, int wc, int fr, int fq) const {
        const int row0 = u.pm * BM + wr * 64 + fr, col0 = u.pn * BM + wc * 32 + 8 * fq; const bool gate = u.pn >= 8;
#pragma unroll
        for (int ai = 0; ai < 2; ++ai)
#pragma unroll
            for (int m = 0; m < 4; ++m) { const int row = row0 + ai * HALF + m * 16; const float rstd = rstd_of(rs_get(rs[row]), inv_n); bf16_t* rowp = Z + (size_t)row * ldz + col0;
#pragma unroll
                for (int bj = 0; bj < 2; ++bj) { const f32x4 v0 = acc[ai][bj][m][0] * rstd, v1 = acc[ai][bj][m][1] * rstd;
                    u32x4 w; w.x = cvt_pk_bf16(v0[0], v0[1]); w.y = cvt_pk_bf16(v0[2], v0[3]); w.z = cvt_pk_bf16(v1[0], v1[1]); w.w = cvt_pk_bf16(v1[2], v1[3]);
                    if (gate) { const int cb = (u.pn - 8) * 16 + bj * 8 + wc * 2 + (fq >> 1); *(u32x4*)(UGb + ((size_t)cb * Mrows + row) * 16 + 8 * (fq & 1)) = w; }
                    else *(u32x4*)(rowp + bj * HALF) = w; } }
    }
};
struct EpiGate {
    static constexpr bool PERM = true, AFTER_DRAIN = false;
    const bf16_t* cvb; const float* ba; const float* bx; const float* ls; unsigned* GAB; int Mrows;
    __device__ __forceinline__ void operator()(const f32x4 (&acc)[2][2][4][2], const Unit& u, int wr, int wc, int fr, int fq) const {
        const int row0 = u.pm * BM + wr * 64 + fr, ch0 = u.pn * HALF + wc * 32 + 8 * fq;
        unsigned* gbase = GAB + ((size_t)(u.pn * 8 + wc * 2 + (fq >> 1)) * Mrows) * 16 + 8 * (fq & 1);
#pragma unroll
        for (int n = 0; n < 2; ++n) { const f32x4 bav = *(const f32x4*)(ba + ch0 + n * 4) * -1.4426950408889634f, bxv = *(const f32x4*)(bx + ch0 + n * 4) * -1.4426950408889634f, lsv = *(const f32x4*)(ls + ch0 + n * 4) * 8.0f;
#pragma unroll
            for (int ai = 0; ai < 2; ++ai)
#pragma unroll
                for (int m = 0; m < 4; ++m) { const int row = row0 + ai * HALF + m * 16; const bool first = (row < 8192) && ((row & 2047) == 0);
                    const u32x2 cw = *(const u32x2*)(cvb + (size_t)row * 1024 + ch0 + n * 4); const float cv[4] = {bf_lo(cw.x), bf_hi(cw.x), bf_lo(cw.y), bf_hi(cw.y)}; u32x4 w;
#pragma unroll
                    for (int e = 0; e < 4; ++e) {
                        const float r = __builtin_amdgcn_rcpf(1.0f + __builtin_amdgcn_exp2f(__builtin_fmaf(acc[ai][0][m][n][e], -1.4426950408889634f, bav[e])));
                        const float ig = __builtin_amdgcn_rcpf(1.0f + __builtin_amdgcn_exp2f(__builtin_fmaf(acc[ai][1][m][n][e], -1.4426950408889634f, bxv[e])));
                        float la = r * lsv[e]; const float x2 = la + la, a2 = __builtin_amdgcn_exp2f(x2 * 1.4426950408889634f);
                        const float om = (x2 > -0.1f) ? -x2 * (1.0f + x2 * (0.5f + x2 * (0.16666667f + x2 * 0.041666668f))) : 1.0f - a2;
                        float mult = __builtin_amdgcn_sqrtf(om);
                        if (first) { la = -30.0f; mult = 1.f; }
                        w[e] = cvt_pk_bf16(la, mult * ig * cv[e]); }
                    *(u32x4*)(gbase + (size_t)row * 16 + n * 4) = w;
                    asm volatile("" ::: "memory"); } }
    }
};
struct EpiPool {
    static constexpr bool PERM = true, AFTER_DRAIN = false;
    bf16_t* Y; int ldy; const float* scale;
    __device__ __forceinline__ void operator()(const f32x4 (&acc)[2][2][4][2], const Unit& u, int wr, int wc, int fr, int fq) const {
        const int row0 = u.pm * BM + wr * 64 + fr, col0 = u.pn * BM + wc * 32 + 8 * fq;
#pragma unroll
        for (int bj = 0; bj < 2; ++bj) { const f32x4 s0 = *(const f32x4*)(scale + col0 + bj * HALF), s1 = *(const f32x4*)(scale + col0 + bj * HALF + 4);
#pragma unroll
            for (int ai = 0; ai < 2; ++ai)
#pragma unroll
                for (int m = 0; m < 4; ++m) { bf16_t* rowp = Y + (size_t)(row0 + ai * HALF + m * 16) * ldy + col0 + bj * HALF;
                    const f32x4 v0 = acc[ai][bj][m][0] * s0, v1 = acc[ai][bj][m][1] * s1;
                    u32x4 w; w.x = cvt_pk_bf16(v0[0], v0[1]); w.y = cvt_pk_bf16(v0[2], v0[3]); w.z = cvt_pk_bf16(v1[0], v1[1]); w.w = cvt_pk_bf16(v1[2], v1[3]);
                    *(u32x4*)rowp = w; } }
    }
};

template <class Epi, class Sched, bool ALIGN_EPI = false, bool SP2 = false>
__device__ __forceinline__ void gemm_phase(PG8_LAS unsigned char* lds, const Gemm g, const Sched& S, const Epi& E) {
    int tid_ = threadIdx.x; asm volatile("" : "+v"(tid_));
    const int tid = tid_, wid = __builtin_amdgcn_readfirstlane(tid >> 6), lane = tid & 63, wr = wid >> 2, wc = wid & 3, fr = lane & 15, fq = lane >> 4;
    const int K = g.K;
    unsigned voffA[2], voffB[2];
#pragma unroll
    for (int i = 0; i < 2; ++i) { int R, C; stage_rc(tid * 16 + i * 8192, R, C); const int Rb = Epi::PERM ? ((R & ~31) + perm32(R & 31)) : R;
        voffA[i] = (unsigned)(R * g.lda + C) * 2u; voffB[i] = (unsigned)(Rb * K + C) * 2u; }
    const size_t kstep = (size_t)(BK * 2);
    const size_t hA = (size_t)HALF * g.lda * 2, hB = (size_t)HALF * K * 2;
    const size_t tA = 2 * hA, tB = 2 * hB;
    const unsigned ldsw = (unsigned)wid * 1024u;
    const int aoff = lds_byte(wr * 64 + fr, fq * 8), boff = lds_byte(wc * 32 + fr, fq * 8);
#define PG8_SA(b, h) (((b) * 2 + (h)) * HTB)
#define PG8_SB(b, h) ((4 + (b) * 2 + (h)) * HTB)
#define PG8_STAGE(bufoff, gbase, voff) do { _Pragma("unroll") for (int _i = 0; _i < 2; ++_i) \
        __builtin_amdgcn_global_load_lds((const unsigned*)((const char*)(gbase) + (voff)[_i]), (PG8_LAS unsigned*)(lds + (bufoff) + ldsw + _i * 8192), 16, 0, 0); } while (0)
#define PG8_LDA(dst, b, h) do { _Pragma("unroll") for (int m = 0; m < 4; ++m) _Pragma("unroll") for (int k = 0; k < 2; ++k) dst[m][k] = *(const PG8_LAS bf16x8*)(lds + PG8_SA(b, h) + aoff + m * 2048 + k * 1024); } while (0)
#define PG8_LDB(dst, b, h) do { _Pragma("unroll") for (int n = 0; n < 2; ++n) _Pragma("unroll") for (int k = 0; k < 2; ++k) dst[n][k] = *(const PG8_LAS bf16x8*)(lds + PG8_SB(b, h) + boff + n * 2048 + k * 1024); } while (0)
#define PG8_MMA(ai, bj, At, Bt) do { __builtin_amdgcn_s_setprio(1); _Pragma("unroll") for (int m = 0; m < 4; ++m) _Pragma("unroll") for (int n = 0; n < 2; ++n) _Pragma("unroll") for (int k = 0; k < 2; ++k) \
        acc[ai][bj][m][n] = __builtin_amdgcn_mfma_f32_16x16x32_bf16(Bt[n][k], At[m][k], acc[ai][bj][m][n], 0, 0, 0); __builtin_amdgcn_s_setprio(0); } while (0)
#define PG8_WAIT_V(n) asm volatile("s_waitcnt vmcnt(" #n ")" ::: "memory")
#define PG8_WAIT_L(n) asm volatile("s_waitcnt lgkmcnt(" #n ")" ::: "memory")
#define PG8_BAR __builtin_amdgcn_s_barrier()
#define PG8_SCHED __builtin_amdgcn_sched_barrier(0)
    Unit cur, nxt; int ui = 0;
    if (!S.next(0, cur)) return;
    f32x4 acc[2][2][4][2];
#pragma unroll
    for (int a = 0; a < 2; ++a)
#pragma unroll
        for (int b = 0; b < 2; ++b)
#pragma unroll
            for (int m = 0; m < 4; ++m)
#pragma unroll
                for (int n = 0; n < 2; ++n) acc[a][b][m][n] = (f32x4){0.f, 0.f, 0.f, 0.f};
    bf16x8 At[4][2], B0[2][2], B1[2][2];
    const char* cA = (const char*)g.A + (size_t)cur.pm * tA + (size_t)cur.ka * 2; const char* cB = (const char*)g.Bt + (size_t)cur.pn * tB + (size_t)cur.kb * 2; int nt = cur.nt;
    S.a_ready(cur);
    if constexpr (SP2) {
        PG8_STAGE(PG8_SB(0, 0), cB, voffB); PG8_STAGE(PG8_SB(0, 1), cB + hB, voffB); PG8_STAGE(PG8_SA(0, 0), cA, voffA); PG8_STAGE(PG8_SA(0, 1), cA + hA, voffA);
        if (wr == 1) PG8_BAR;
        PG8_WAIT_V(2); PG8_BAR;
        PG8_STAGE(PG8_SB(1, 0), cB + kstep, voffB); PG8_STAGE(PG8_SA(1, 0), cA + kstep, voffA); PG8_STAGE(PG8_SB(1, 1), cB + hB + kstep, voffB);
        PG8_WAIT_V(6); PG8_BAR;
    } else {
        PG8_STAGE(PG8_SB(0, 0), cB, voffB); PG8_STAGE(PG8_SA(0, 0), cA, voffA); PG8_STAGE(PG8_SB(0, 1), cB + hB, voffB); PG8_STAGE(PG8_SA(0, 1), cA + hA, voffA);
        if (wr == 1) PG8_BAR;
        PG8_WAIT_V(4); PG8_BAR;
        PG8_STAGE(PG8_SB(1, 0), cB + kstep, voffB); PG8_STAGE(PG8_SA(1, 0), cA + kstep, voffA); PG8_STAGE(PG8_SB(1, 1), cB + hB + kstep, voffB);
        PG8_WAIT_V(6); PG8_BAR;
    }
    for (;;) {
        const bool has_next = S.next(ui + 1, nxt);
        const char* nA = has_next ? (const char*)g.A + (size_t)nxt.pm * tA + (size_t)nxt.ka * 2 : cA; const char* nB = has_next ? (const char*)g.Bt + (size_t)nxt.pn * tB + (size_t)nxt.kb * 2 : cB;
#pragma nounroll
        for (int t = 0; t < nt; t += 2) {
            const bool last = (t == nt - 2);
            const char* a1 = cA + (size_t)(t + 1) * kstep;
            const char* a2 = last ? nA : cA + (size_t)(t + 2) * kstep; const char* b2 = last ? nB : cB + (size_t)(t + 2) * kstep;
            const char* a3 = a2 + kstep; const char* b3 = b2 + kstep;
            if (last && has_next) S.a_ready(nxt);
            if constexpr (SP2) {
            PG8_LDB(B0, 0, 0); PG8_LDB(B1, 0, 1); PG8_SCHED; PG8_LDA(At, 0, 0); PG8_STAGE(PG8_SA(1, 1), a1 + hA, voffA);
            PG8_WAIT_V(8); PG8_WAIT_L(0); PG8_BAR; PG8_MMA(0, 0, At, B0); PG8_MMA(0, 1, At, B1); PG8_BAR; PG8_SCHED;
            PG8_LDA(At, 0, 1); PG8_STAGE(PG8_SB(0, 0), b2, voffB); PG8_STAGE(PG8_SB(0, 1), b2 + hB, voffB); PG8_STAGE(PG8_SA(0, 0), a2, voffA);
            PG8_WAIT_V(8); PG8_WAIT_L(0); PG8_BAR; PG8_MMA(1, 0, At, B0); PG8_MMA(1, 1, At, B1); PG8_BAR; PG8_SCHED;
            PG8_LDB(B0, 1, 0); PG8_LDB(B1, 1, 1); PG8_SCHED; PG8_LDA(At, 1, 0); PG8_STAGE(PG8_SA(0, 1), a2 + hA, voffA);
            PG8_WAIT_V(8); PG8_WAIT_L(0); PG8_BAR; PG8_MMA(0, 0, At, B0); PG8_MMA(0, 1, At, B1); PG8_BAR; PG8_SCHED;
            PG8_LDA(At, 1, 1); PG8_STAGE(PG8_SB(1, 0), b3, voffB); PG8_STAGE(PG8_SB(1, 1), b3 + hB, voffB); PG8_STAGE(PG8_SA(1, 0), a3, voffA);
            PG8_WAIT_V(8); PG8_WAIT_L(0); PG8_BAR; PG8_MMA(1, 0, At, B0); PG8_MMA(1, 1, At, B1); PG8_BAR; PG8_SCHED;
            } else {
            PG8_LDB(B0, 0, 0); PG8_SCHED; PG8_LDA(At, 0, 0); PG8_STAGE(PG8_SA(1, 1), a1 + hA, voffA);
            PG8_WAIT_L(8); PG8_BAR; PG8_WAIT_L(0); PG8_MMA(0, 0, At, B0); PG8_BAR; PG8_SCHED;
            PG8_LDB(B1, 0, 1); PG8_STAGE(PG8_SB(0, 0), b2, voffB);
            PG8_BAR; PG8_WAIT_L(0); PG8_MMA(0, 1, At, B1); PG8_BAR;
            PG8_LDA(At, 0, 1); PG8_STAGE(PG8_SA(0, 0), a2, voffA);
            PG8_BAR; PG8_WAIT_L(0); PG8_MMA(1, 0, At, B0); PG8_BAR; PG8_SCHED;
            PG8_STAGE(PG8_SB(0, 1), b2 + hB, voffB);
            PG8_WAIT_V(6); PG8_BAR; PG8_MMA(1, 1, At, B1); PG8_BAR;
            PG8_LDB(B0, 1, 0); PG8_SCHED; PG8_LDA(At, 1, 0); PG8_STAGE(PG8_SA(0, 1), a2 + hA, voffA);
            PG8_WAIT_L(8); PG8_BAR; PG8_WAIT_L(0); PG8_MMA(0, 0, At, B0); PG8_BAR; PG8_SCHED;
            PG8_LDB(B1, 1, 1); PG8_STAGE(PG8_SB(1, 0), b3, voffB);
            PG8_BAR; PG8_WAIT_L(0); PG8_MMA(0, 1, At, B1); PG8_BAR;
            PG8_LDA(At, 1, 1); PG8_STAGE(PG8_SA(1, 0), a3, voffA);
            PG8_BAR; PG8_WAIT_L(0); PG8_MMA(1, 0, At, B0); PG8_BAR; PG8_SCHED;
            PG8_STAGE(PG8_SB(1, 1), b3 + hB, voffB);
            PG8_WAIT_V(6); PG8_BAR; PG8_MMA(1, 1, At, B1); PG8_BAR;
            }
        }
        if constexpr (ALIGN_EPI) { if (wr == 0) PG8_BAR; }
        if constexpr (!Epi::AFTER_DRAIN) { E(acc, cur, wr, wc, fr, fq); S.done(cur); }
        if (!has_next) break;
#pragma unroll
        for (int a = 0; a < 2; ++a)
#pragma unroll
            for (int b = 0; b < 2; ++b)
#pragma unroll
                for (int m = 0; m < 4; ++m)
#pragma unroll
                    for (int n = 0; n < 2; ++n) acc[a][b][m][n] = (f32x4){0.f, 0.f, 0.f, 0.f};
        cur = nxt; cA = nA; cB = nB; nt = cur.nt; ++ui;
        if constexpr (ALIGN_EPI) { if (wr == 1) PG8_BAR; }
    }
    PG8_WAIT_V(0);
    if constexpr (!ALIGN_EPI) { if (wr == 0) PG8_BAR; }
    PG8_BAR;
    if constexpr (Epi::AFTER_DRAIN) { E.fused(acc, cur, wr, wc, fr, fq, lds, wid, lane); S.done(cur); }
#undef PG8_SA
#undef PG8_SB
#undef PG8_STAGE
#undef PG8_LDA
#undef PG8_LDB
#undef PG8_MMA
#undef PG8_WAIT_V
#undef PG8_WAIT_L
#undef PG8_BAR
#undef PG8_SCHED
}
}

constexpr int D = 2048, NBP = 4, SEQ = 2048, NBS = 128, DSQ = 8, MP = NBP * SEQ, MS = NBS * DSQ, M = MP + MS;
constexpr int DFF = 5504, NFF = 2 * DFF, DPOOL = 1024, DRNN = 1024, DINE = 3072, POOLBUF = 15, NGRP = 128, NST = 64;
constexpr int NWAVES = 8, NTHR = 512;
constexpr float INV_D = 1.0f / 2048.0f;

constexpr size_t MiB = 1u << 20;
constexpr size_t WS_CTL = 0, CTL_ZERO_BYTES = 2 * MiB;
constexpr int CW_TMO = 0, CW_BAR = 4096, CW_FLAG = 8192;
constexpr size_t WS_RS = 64 * 1024;
constexpr int NRS = 14;
static_assert(WS_RS + (size_t)NRS * M * 8 <= CTL_ZERO_BYTES, "RS inside the memset region");
constexpr size_t SZ_FIN = (size_t)NFF * D * 2, SZ_FOUT = (size_t)D * DFF * 2, SZ_EIN = (size_t)DINE * D * 2, SZ_EOUT = (size_t)D * D * 2, SZ_POOL = (size_t)1024 * 256 * 2, SZ_GATE = (size_t)2048 * 256 * 2, SZ_GLU = (size_t)4096 * D * 2;
constexpr size_t WS_FIN = 2 * MiB, WS_FOUT = WS_FIN + 8 * SZ_FIN, WS_EIN = WS_FOUT + 8 * SZ_FOUT, WS_EOUT = WS_EIN + 2 * SZ_EIN, WS_POOL = WS_EOUT + 2 * SZ_EOUT, WS_GATE = WS_POOL + 2 * SZ_POOL, WS_GLU = WS_GATE + 2 * SZ_GATE;
constexpr size_t WS_AB = WS_GLU + 2 * SZ_GLU;
constexpr size_t WS_BB = WS_AB + (size_t)2 * 128 * 64 * 2 * 4;
constexpr size_t WS_LS = WS_BB + (size_t)2 * 128 * 64 * 32 * 4;
constexpr size_t WS_W1 = (WS_LS + 2 * 1024 * 4 + 255) / 256 * 256;
constexpr size_t WS_XB = WS_W1 + (size_t)2 * 128 * 128 * 256 * 2;
constexpr size_t WS_ACT = WS_XB + (size_t)M * D * 2;
constexpr size_t WS_H = WS_ACT;
constexpr size_t WS_Z = WS_ACT;
constexpr size_t WS_DP = WS_Z + (size_t)M * DINE * 4;
constexpr size_t WS_CV = WS_DP + (size_t)M * 1024 * 2;
constexpr size_t WS_CVF = WS_CV + (size_t)M * 1024 * 2;
constexpr size_t WS_GA = WS_CVF + (size_t)M * 1024 * 4;
constexpr size_t WS_GB = WS_GA + (size_t)M * 1024 * 4;
constexpr size_t WS_Y2 = WS_GB + (size_t)M * 1024 * 4;
constexpr size_t WS_UGB = WS_Y2 + (size_t)M * D * 2;
constexpr size_t WS_PART = WS_DP;
constexpr size_t WS_END = WS_UGB + (size_t)M * 1024 * 4;
static_assert(WS_H + (size_t)M * DFF * 2 <= WS_DP, "H overlays Z only");
static_assert(WS_PART + (size_t)256 * 65536 * 2 <= WS_END, "partial slabs fit");

constexpr size_t O_YP = 0, O_YS = O_YP + (size_t)MP * D, O_POOLP = O_YS + (size_t)MS * D, O_POOLS = O_POOLP + (size_t)2 * NBP * 15 * 1024, O_CONVP = O_POOLS + (size_t)2 * NBS * 15 * 1024,
                 O_CONVS = O_CONVP + (size_t)2 * NBP * 3 * 1024, O_HP = O_CONVS + (size_t)2 * NBS * 3 * 1024, O_HS = O_HP + (size_t)2 * NBP * 1024, O_REP = O_HS + (size_t)2 * NBS * 1024,
                 O_RES = O_REP + (size_t)2 * NBP * 128 * 64, O_IMP = O_RES + (size_t)2 * NBS * 128 * 64, O_IMS = O_IMP + (size_t)2 * NBP * 128 * 64, O_END = O_IMS + (size_t)2 * NBS * 128 * 64;

constexpr int RING_OFF = 0, RING_BYTES = 131072;
constexpr int LDSCTL_OFF = RING_BYTES, MISC_OFF = LDSCTL_OFF + 320;
constexpr int LDS_BYTES = 147456;
static_assert(MISC_OFF + 128 <= LDS_BYTES, "LDS map");

#define GAS __attribute__((address_space(1)))
#define LAS __attribute__((address_space(3)))
typedef unsigned short bf16;
typedef unsigned v4u __attribute__((ext_vector_type(4)));
typedef unsigned v2u __attribute__((ext_vector_type(2)));
typedef float f32x4 __attribute__((ext_vector_type(4)));
typedef GAS unsigned gu32;
#define RLX_AGENT __ATOMIC_RELAXED, __HIP_MEMORY_SCOPE_AGENT
#define LDS_WAIT() asm volatile("s_waitcnt lgkmcnt(0)" ::: "memory")
#define VM_WAIT() asm volatile("s_waitcnt vmcnt(0)" ::: "memory")
__device__ __forceinline__ unsigned f2bf(float f) { unsigned u = __builtin_bit_cast(unsigned, f); return (u + 0x7fffu + ((u >> 16) & 1u)) >> 16; }
typedef __bf16 bf16x2v __attribute__((ext_vector_type(2)));
typedef float f32x2c __attribute__((ext_vector_type(2)));
__device__ __forceinline__ unsigned pk2(float lo, float hi) { const bf16x2v b = __builtin_convertvector((f32x2c){lo, hi}, bf16x2v); return __builtin_bit_cast(unsigned, b); }
__device__ __forceinline__ float bf_lo(unsigned u) { return __builtin_bit_cast(float, u << 16); }
__device__ __forceinline__ float bf_hi(unsigned u) { return __builtin_bit_cast(float, u & 0xffff0000u); }
__device__ __forceinline__ float wave_sum(float v) {
#pragma unroll
    for (int o = 1; o < 64; o <<= 1) v += __shfl_xor(v, o);
    return v;
}
__device__ __forceinline__ float gelu_tanh(float v) { const float z = 1.5957691216057308f * (v + 0.044715f * v * v * v); return v * __builtin_amdgcn_rcpf(1.0f + __expf(-z)); }

#define XB_TMO      128
#define XB_XCNT(j)  (256  + 64 * (j))
#define XB_XSUB(j)  (1280 + 64 * (j))
#define XB_XGEN(j)  (2304 + 64 * (j))
#define XB_TOP      3328
#define XB_TOPGEN   3392
#define XCD_BAR_WORDS 3456
#define XB_SPIN_CAP (1u << 18)

__device__ __forceinline__ unsigned xb_ld(unsigned* p)              { return __hip_atomic_load(p, __ATOMIC_RELAXED, __HIP_MEMORY_SCOPE_AGENT); }
__device__ __forceinline__ unsigned xb_add(unsigned* p, unsigned v) { return __hip_atomic_fetch_add(p, v, __ATOMIC_RELAXED, __HIP_MEMORY_SCOPE_AGENT); }
__device__ __forceinline__ unsigned xb_xcc_id() { return (unsigned)__builtin_amdgcn_s_getreg((3 << 11) | 20) & 0xFu; }
#define XB_SPIN(cond, bar) do { unsigned _sp = 0; while (cond) { __builtin_amdgcn_s_sleep(1); \
    if ((++_sp & 255u) == 0u) { if (xb_ld(&(bar)[XB_TMO])) break; if (_sp > XB_SPIN_CAP) { atomicAdd(&(bar)[XB_TMO], 1u); break; } } } } while (0)

struct XcdBarrier {
    unsigned* bar; unsigned x;
    volatile LAS unsigned* st;
};

__device__ __forceinline__ XcdBarrier xcd_barrier_post(unsigned* bar, volatile LAS unsigned* st) {
    XcdBarrier b; b.bar = bar; b.x = xb_xcc_id(); b.st = st;
    if (threadIdx.x == 0) (void)xb_add(&bar[XB_XCNT(b.x)], 1u);
    return b;
}
__device__ __forceinline__ void xcd_barrier_complete(unsigned* bar, unsigned x, unsigned& nloc, unsigned& nx) {
    const unsigned G = gridDim.x * gridDim.y * gridDim.z;
    unsigned sum, cnt, mine, sp = 0u;
    for (;;) {
        sum = 0u; cnt = 0u; mine = 0u;
#pragma unroll
        for (unsigned j = 0; j < 16; ++j) { const unsigned c = xb_ld(&bar[XB_XCNT(j)]); sum += c; cnt += (c > 0u) ? 1u : 0u; mine = (j == x) ? c : mine; }
        if (sum == G) break;
        __builtin_amdgcn_s_sleep(1);
        if ((++sp & 255u) == 0u) { if (xb_ld(&bar[XB_TMO])) break; if (sp > XB_SPIN_CAP) { atomicAdd(&bar[XB_TMO], 1u); break; } }
    }
    nloc = mine > 0u ? mine : 1u; nx = cnt > 0u ? cnt : 1u;
}

__device__ __forceinline__ void xcd_barrier(const XcdBarrier& b) {
    asm volatile("s_waitcnt vmcnt(0)" ::: "memory");
    __syncthreads();
    if (threadIdx.x == 0) {
        unsigned* bar = b.bar;
        __builtin_amdgcn_s_waitcnt(0);
        unsigned nloc = b.st[0], nx = b.st[1];
        if (nloc == 0u) { xcd_barrier_complete(bar, b.x, nloc, nx); b.st[0] = nloc; b.st[1] = nx; }
        const unsigned old = xb_add(&bar[XB_XSUB(b.x)], 1u);
        const unsigned gen = old / nloc;
        if (old + 1u == (gen + 1u) * nloc) {
            __builtin_amdgcn_fence(__ATOMIC_RELEASE, "agent");
            asm volatile("s_waitcnt vmcnt(0)" ::: "memory");
            const unsigned og = xb_add(&bar[XB_TOP], 1u);
            const unsigned tg = og / nx;
            if (og + 1u == (tg + 1u) * nx) xb_add(&bar[XB_TOPGEN], 1u);
            else XB_SPIN(xb_ld(&bar[XB_TOPGEN]) == tg, bar);
            __builtin_amdgcn_fence(__ATOMIC_ACQUIRE, "agent");
            xb_add(&bar[XB_XGEN(b.x)], 1u);
            asm volatile("s_waitcnt vmcnt(0)" ::: "memory");
        } else {
            XB_SPIN(xb_ld(&bar[XB_XGEN(b.x)]) == gen, bar);
            __builtin_amdgcn_fence(__ATOMIC_ACQUIRE, "agent");
            asm volatile("s_waitcnt vmcnt(0)" ::: "memory");
        }
    }
    __syncthreads();
}
struct Args { const float* in[35]; float* out; unsigned char* ws; int lo, hi; };

struct CvtJob { const float* W; const float* ks; bf16* dst; int ldw, K, Nd, kind, HO, ldd; };
__device__ __forceinline__ void cvt_item(const CvtJob& j, int item, int lane, LAS unsigned* T) {
    const int nblk = j.Nd >> 6, kb = item / nblk, nb = item - kb * nblk, k0 = kb * 64, n0 = nb * 64;
    int sc0 = n0; if (j.kind == 1) sc0 = ((n0 >> 7) & 1) * j.HO + (n0 >> 8) * 128 + (n0 & 127);
    const float* src = j.W + (size_t)k0 * j.ldw + sc0 + lane;
    float v[64];
#pragma unroll
    for (int kk = 0; kk < 64; ++kk) v[kk] = __builtin_nontemporal_load(src + (size_t)kk * j.ldw);
    if (j.ks) {
#pragma unroll
        for (int kk = 0; kk < 64; ++kk) v[kk] *= j.ks[k0 + kk]; }
#pragma unroll
    for (int q = 0; q < 8; ++q) { v4u o; o.x = pk2(v[8 * q], v[8 * q + 1]); o.y = pk2(v[8 * q + 2], v[8 * q + 3]); o.z = pk2(v[8 * q + 4], v[8 * q + 5]); o.w = pk2(v[8 * q + 6], v[8 * q + 7]); *(LAS v4u*)(T + lane * 36 + 4 * q) = o; }
    LDS_WAIT(); asm volatile("" ::: "memory");
    const int c = lane & 7, r0 = lane >> 3;
#pragma unroll
    for (int i = 0; i < 8; ++i) { const int r = r0 + 8 * i; const v4u o = *(const LAS v4u*)(T + r * 36 + 4 * c); *(v4u*)(j.dst + (size_t)(n0 + r) * j.ldd + k0 + 8 * c) = o; }
    LDS_WAIT(); asm volatile("" ::: "memory");
}
constexpr int NJOBS = 62;
__device__ __forceinline__ CvtJob get_job(int jj, const Args& a) {
    CvtJob j; j.kind = 0; j.HO = 0; j.ks = nullptr; unsigned char* ws = a.ws;
    if (jj < 16) { const int l = jj >> 2, w = jj & 3, fi = 2 * l + (w >> 1);
        if ((w & 1) == 0) { j.W = a.in[w == 0 ? 8 : 12] + (size_t)l * D * NFF; j.ldw = NFF; j.K = D; j.Nd = NFF; j.kind = 1; j.HO = DFF; j.dst = (bf16*)(ws + WS_FIN + fi * SZ_FIN); j.ldd = D; j.ks = a.in[w == 0 ? 7 : 11] + l * D; }
        else { j.W = a.in[w == 1 ? 9 : 13] + (size_t)l * DFF * D; j.ldw = D; j.K = DFF; j.Nd = D; j.dst = (bf16*)(ws + WS_FOUT + fi * SZ_FOUT); j.ldd = DFF; } }
    else if (jj < 18) { const int e = jj - 16; j.W = a.in[14] + (size_t)e * D * DINE; j.ldw = DINE; j.K = D; j.Nd = DINE; j.dst = (bf16*)(ws + WS_EIN + e * SZ_EIN); j.ldd = D; j.ks = a.in[10] + (2 * e) * D; }
    else if (jj < 20) { const int e = jj - 18; j.W = a.in[24] + (size_t)e * D * D; j.ldw = D; j.K = D; j.Nd = D; j.dst = (bf16*)(ws + WS_EOUT + e * SZ_EOUT); j.ldd = D; }
    else if (jj < 22) { const int o = jj - 20; j.W = a.in[33] + (size_t)o * D * 4096; j.ldw = 4096; j.K = D; j.Nd = 4096; j.kind = 1; j.HO = 2048; j.dst = (bf16*)(ws + WS_GLU + o * SZ_GLU); j.ldd = D; }
    else if (jj < 30) { const int q = jj - 22, e = q >> 2, g = q & 3; j.W = a.in[15] + (size_t)(e * 4 + g) * 65536; j.ldw = 256; j.K = 256; j.Nd = 256; j.dst = (bf16*)(ws + WS_POOL + e * SZ_POOL) + (size_t)(g * 256) * 256; j.ldd = 256; }
    else { const int q = jj - 30, e = q >> 4, r = q & 15, isx = r >> 3, h = r & 7; j.W = a.in[isx ? 21 : 19] + (size_t)(e * 8 + h) * 16384; j.ldw = 128; j.K = 128; j.Nd = 128;
        j.dst = (bf16*)(ws + WS_GATE + e * SZ_GATE) + (size_t)(256 * h + 128 * isx) * 256 + (h & 1) * 128; j.ldd = 256; }
    return j;
}
__device__ const unsigned char CVT_JOBS[62] = { 0,      1, 22, 23, 24, 25, 26, 27, 28, 29, 30, 31, 32, 33, 34, 35, 36, 37, 38, 39, 40, 41, 42, 43, 44, 45, 46, 47, 48, 49, 50, 51, 52, 53, 54, 55, 56, 57, 58, 59, 60, 61,
                                                16, 18, 2, 3,      4, 5, 20,      6, 7,      8, 9, 17, 19,      10, 11,      12, 13, 21,      14, 15   };
__device__ const unsigned char CVT_STAGE_START[9] = { 0, 1, 46, 49, 51, 55, 57, 60, 62 };
__device__ __forceinline__ void cvt_stage(const Args& a, int stage, int widx, int nw, int lane, LAS unsigned* T) {
    int off = 0;
    for (int q = CVT_STAGE_START[stage]; q < CVT_STAGE_START[stage + 1]; ++q) { const CvtJob j = get_job(CVT_JOBS[q], a); const int nitems = (j.K >> 6) * (j.Nd >> 6);
        int first = widx - off; if (first < 0) first += nw;
        for (int it = first; it < nitems; it += nw) cvt_item(j, it, lane, T);
        off = (off + nitems) % nw; }
}
__device__ __forceinline__ void p0_prologue(const Args& a, LAS unsigned char* lds) {
    int tid = threadIdx.x; asm volatile("" : "+v"(tid)); const int lane = tid & 63, wave = __builtin_amdgcn_readfirstlane(tid >> 6);
    const int G = gridDim.x, gw = blockIdx.x * NWAVES + wave, NGW = G * NWAVES; unsigned char* ws = a.ws;
    cvt_stage(a, 0, gw, NGW, lane, (LAS unsigned*)(lds + RING_OFF + wave * 9216));
    { const int gt = blockIdx.x * NTHR + tid, NT = G * NTHR;
      for (int i = gt; i < 2 * 8 * 256 * 16; i += NT) { const int ch = i & 15, r = (i >> 4) & 255, h = (i >> 12) & 7, e = i >> 15;
          *(v4u*)((bf16*)(ws + WS_GATE + e * SZ_GATE) + (size_t)(256 * h + r) * 256 + ((h & 1) ^ 1) * 128 + ch * 8) = (v4u){0u, 0u, 0u, 0u}; }
      for (int i = (tid < 64 ? (int)blockIdx.x * 64 + tid : 2 * 128 * 64); i < 2 * 128 * 64; i += G * 64) { const int og = i >> 6, p = i & 63;
          const float lr = fminf(a.in[25][i], -1e-4f), li = a.in[26][i], dt = expf(a.in[27][og]);
          const float mag = expf(lr * dt), abr = mag * cosf(li * dt), abi = mag * sinf(li * dt), den = lr * lr + li * li, nr = abr - 1.0f;
          const float fre = (nr * lr + abi * li) / den, fim = (abi * lr - nr * li) / den;
          float* AB = (float*)(ws + WS_AB) + (size_t)i * 2; AB[0] = abr; AB[1] = abi;
          float* BB = (float*)(ws + WS_BB) + (size_t)i * 32; const float* br = a.in[28] + (size_t)i * 16; const float* bi = a.in[29] + (size_t)i * 16;
          float bre[16], bim[16];
#pragma unroll
          for (int c = 0; c < 16; ++c) { bre[c] = fre * br[c] - fim * bi[c]; bim[c] = fre * bi[c] + fim * br[c]; BB[c] = bre[c]; BB[16 + c] = bim[c]; }
          bf16* W1t = (bf16*)(ws + WS_W1) + (size_t)og * 128 * 256; float pr = 1.f, pi = 0.f;
          const int ppr_ = 2 * p, ppi_ = 2 * p + 1;
          for (int n = 0; n < 16; ++n) { const int s = 15 - n; v4u wr0, wr1, wi0, wi1;
              wr0.x = pk2(pr * bre[0] - pi * bim[0], pr * bre[1] - pi * bim[1]); wr0.y = pk2(pr * bre[2] - pi * bim[2], pr * bre[3] - pi * bim[3]); wr0.z = pk2(pr * bre[4] - pi * bim[4], pr * bre[5] - pi * bim[5]); wr0.w = pk2(pr * bre[6] - pi * bim[6], pr * bre[7] - pi * bim[7]);
              wr1.x = pk2(pr * bre[8] - pi * bim[8], pr * bre[9] - pi * bim[9]); wr1.y = pk2(pr * bre[10] - pi * bim[10], pr * bre[11] - pi * bim[11]); wr1.z = pk2(pr * bre[12] - pi * bim[12], pr * bre[13] - pi * bim[13]); wr1.w = pk2(pr * bre[14] - pi * bim[14], pr * bre[15] - pi * bim[15]);
              wi0.x = pk2(pr * bim[0] + pi * bre[0], pr * bim[1] + pi * bre[1]); wi0.y = pk2(pr * bim[2] + pi * bre[2], pr * bim[3] + pi * bre[3]); wi0.z = pk2(pr * bim[4] + pi * bre[4], pr * bim[5] + pi * bre[5]); wi0.w = pk2(pr * bim[6] + pi * bre[6], pr * bim[7] + pi * bre[7]);
              wi1.x = pk2(pr * bim[8] + pi * bre[8], pr * bim[9] + pi * bre[9]); wi1.y = pk2(pr * bim[10] + pi * bre[10], pr * bim[11] + pi * bre[11]); wi1.z = pk2(pr * bim[12] + pi * bre[12], pr * bim[13] + pi * bre[13]); wi1.w = pk2(pr * bim[14] + pi * bre[14], pr * bim[15] + pi * bre[15]);
              { const size_t fr_ = ((size_t)((ppr_ >> 5) * 2 + ((ppr_ >> 4) & 1)) * 8 + (s >> 1)) * 64, fi_ = ((size_t)((ppi_ >> 5) * 2 + ((ppi_ >> 4) & 1)) * 8 + (s >> 1)) * 64; const int q0_ = 2 * (s & 1);
                *(v4u*)(W1t + (fr_ + q0_ * 16 + (ppr_ & 15)) * 8) = wr0; *(v4u*)(W1t + (fr_ + (q0_ + 1) * 16 + (ppr_ & 15)) * 8) = wr1;
                *(v4u*)(W1t + (fi_ + q0_ * 16 + (ppi_ & 15)) * 8) = wi0; *(v4u*)(W1t + (fi_ + (q0_ + 1) * 16 + (ppi_ & 15)) * 8) = wi1; }
              const float npr = pr * abr - pi * abi, npi = pr * abi + pi * abr; pr = npr; pi = npi; } }
      for (int i = gt; i < 2 * 1024; i += NT) ((float*)(ws + WS_LS))[i] = -log1pf(expf(-a.in[23][i])); }
    bf16* Xb = (bf16*)(ws + WS_XB); pg8::rs_t* rs0 = (pg8::rs_t*)(ws + WS_RS);
    for (int m = gw; m < M; m += NGW) { const float* src = (m < MP) ? a.in[0] + (size_t)m * D : a.in[1] + (size_t)(m - MP) * D;
        float s = 0.f;
#pragma unroll
        for (int q = 0; q < 8; ++q) { const f32x4 v = *((const f32x4*)src + lane + 64 * q);
            v2u w; w.x = pk2(v[0], v[1]); w.y = pk2(v[2], v[3]); *((v2u*)(Xb + (size_t)m * D) + lane + 64 * q) = w;
            const float v0 = bf_lo(w.x), v1 = bf_hi(w.x), v2 = bf_lo(w.y), v3 = bf_hi(w.y); s += (v0 * v0 + v1 * v1) + (v2 * v2 + v3 * v3); }
        s = wave_sum(s); if (lane == 0) rs0[m] = (pg8::rs_t)(s * 1048576.0f + 0.5f); }
}

__device__ __forceinline__ void row_decode(int row, bool& isP, int& b, int& t, int& base) {
    if (row < MP) { isP = true; b = row >> 11; t = row & 2047; base = b << 11; } else { isP = false; const int q = row - MP; b = q >> 3; t = q & 7; base = MP + (b << 3); } }
__device__ __forceinline__ f32x4 ep_fetch(const bf16* Zc, int base, int tt, const float* st, int nbuf) {
    if (tt >= 0) { const v2u w = *(const v2u*)(Zc + (size_t)(base + tt) * 2048); return (f32x4){bf_lo(w.x), bf_hi(w.x), bf_lo(w.y), bf_hi(w.y)}; }
    if (st) return *(const f32x4*)(st + (size_t)(nbuf + tt) * 1024);
    return (f32x4){0.f, 0.f, 0.f, 0.f};
}
__device__ __forceinline__ f32x4 ep_cvt(v2u w) { return (f32x4){bf_lo(w.x), bf_hi(w.x), bf_lo(w.y), bf_hi(w.y)}; }
template <int W, bool FIRST>
__device__ __forceinline__ void ep_pool_fast(const bf16* Zr, bf16* Dr, float* ost, int t0) {
    v2u raw[31 + W];
#pragma unroll
    for (int i = 0; i < 31 + W; ++i) raw[i] = (FIRST && i < W - 1) ? (v2u){0u, 0u} : *(const v2u*)(Zr + (ptrdiff_t)(i - (W - 1)) * 2048);
    f32x4 s = (f32x4){0.f, 0.f, 0.f, 0.f};
    if (!FIRST) {
#pragma unroll
        for (int i = 0; i < W - 1; ++i) s += ep_cvt(raw[i]); }
#pragma unroll
    for (int k = 0; k < 32; ++k) { const f32x4 un = ep_cvt(raw[W - 1 + k]); s += un; const float inv = (FIRST && k + 1 < W) ? 1.0f / (float)(k + 1) : 1.0f / (float)W; const f32x4 d = (FIRST && k + 1 < W) ? s / (float)(k + 1) - un : s * inv - un;
        v2u o; o.x = pk2(d[0], d[1]); o.y = pk2(d[2], d[3]); *(v2u*)(Dr + (size_t)k * 1024) = o;
        if (!FIRST) { if (t0 + k >= SEQ - 15) *(f32x4*)(ost + (size_t)(t0 + k - (SEQ - 15)) * 1024) = un; }
        if (!(FIRST && k < W - 1)) s -= ep_cvt(raw[k]); }
}
template <int W>
__device__ __forceinline__ void ep_pool_sample(const bf16* Zr, bf16* Dr, const float* st, float* ost) {
    f32x4 pv[W - 1]; v2u raw[8]; f32x4 keep[7];
#pragma unroll
    for (int i = 0; i < W - 1; ++i) pv[i] = *(const f32x4*)(st + (size_t)(15 - (W - 1) + i) * 1024);
#pragma unroll
    for (int i = 0; i < 8; ++i) raw[i] = *(const v2u*)(Zr + (size_t)i * 2048);
#pragma unroll
    for (int i = 0; i < 7; ++i) keep[i] = *(const f32x4*)(st + (size_t)(8 + i) * 1024);
    f32x4 s = (f32x4){0.f, 0.f, 0.f, 0.f};
#pragma unroll
    for (int i = 0; i < W - 1; ++i) s += pv[i];
#pragma unroll
    for (int k = 0; k < 8; ++k) { const f32x4 un = ep_cvt(raw[k]); s += un; const f32x4 d = s / (float)W - un;
        v2u o; o.x = pk2(d[0], d[1]); o.y = pk2(d[2], d[3]); *(v2u*)(Dr + (size_t)k * 1024) = o;
        *(f32x4*)(ost + (size_t)(7 + k) * 1024) = un; if (k < 7) *(f32x4*)(ost + (size_t)k * 1024) = keep[k];
        s -= (k < W - 1) ? pv[k < W - 1 ? k : 0] : ep_cvt(raw[k - (W - 1) < 0 ? 0 : k - (W - 1)]); }
}
__device__ __forceinline__ void even_prep(const Args& a, int e) {
    int tid = threadIdx.x; asm volatile("" : "+v"(tid));
    unsigned char* ws = a.ws; const bf16* Z = (const bf16*)(ws + WS_Z); bf16* Dp = (bf16*)(ws + WS_DP); bf16* Cv = (bf16*)(ws + WS_CV);
    const float* spool = a.in[2] + (size_t)e * NBS * 15 * 1024; const float* sconv = a.in[3] + (size_t)e * NBS * 3 * 1024;
    const float* cw = a.in[17] + (size_t)e * 4 * 1024; const float* cb = a.in[18] + (size_t)e * 1024;
    float* o_poolp = a.out + O_POOLP + (size_t)e * NBP * 15 * 1024; float* o_pools = a.out + O_POOLS + (size_t)e * NBS * 15 * 1024;
    float* o_convp = a.out + O_CONVP + (size_t)e * NBP * 3 * 1024; float* o_convs = a.out + O_CONVS + (size_t)e * NBS * 3 * 1024;
    const int NT = gridDim.x * NTHR; constexpr int RUN = 32, NPR = (MP / RUN) * 512, NSR = NBS * 512;
    for (int idx = blockIdx.x * NTHR + tid; idx < NPR + NSR; idx += NT) {
        const bool isP = idx < NPR; const int r = isP ? idx : idx - NPR, q = r & 511, ck = r >> 9;
        const int b = isP ? (ck >> 6) : ck, t0 = isP ? (ck & 63) * RUN : 0, nrun = isP ? RUN : DSQ, base = isP ? b * SEQ : MP + b * DSQ;
        if (q < 256) {
            const int c = q * 4, w = 2 << (c >> 8); const bf16* Zc = Z + c; const float* st = isP ? nullptr : spool + (size_t)b * 15 * 1024 + c;
            { const bf16* Zr = Zc + (size_t)(base + t0) * 2048; bf16* Dr = Dp + (size_t)(base + t0) * 1024 + c;
              if (isP) { float* ost = o_poolp + (size_t)b * 15 * 1024 + c;
                if (t0 != 0) { if (w == 2) ep_pool_fast<2, false>(Zr, Dr, ost, t0); else if (w == 4) ep_pool_fast<4, false>(Zr, Dr, ost, t0); else if (w == 8) ep_pool_fast<8, false>(Zr, Dr, ost, t0); else ep_pool_fast<16, false>(Zr, Dr, ost, t0); }
                else { if (w == 2) ep_pool_fast<2, true>(Zr, Dr, ost, t0); else if (w == 4) ep_pool_fast<4, true>(Zr, Dr, ost, t0); else if (w == 8) ep_pool_fast<8, true>(Zr, Dr, ost, t0); else ep_pool_fast<16, true>(Zr, Dr, ost, t0); } }
              else { float* ost = o_pools + (size_t)b * 15 * 1024 + c;
                if (w == 2) ep_pool_sample<2>(Zr, Dr, st, ost); else if (w == 4) ep_pool_sample<4>(Zr, Dr, st, ost); else if (w == 8) ep_pool_sample<8>(Zr, Dr, st, ost); else ep_pool_sample<16>(Zr, Dr, st, ost); }
              continue; }
            f32x4 s = (f32x4){0.f, 0.f, 0.f, 0.f};
            for (int j = 1; j < w; ++j) s += ep_fetch(Zc, base, t0 - j, st, 15);
            for (int tb = 0; tb < nrun; tb += 8) { f32x4 un[8], uo[8];
#pragma unroll
                for (int k = 0; k < 8; ++k) { un[k] = ep_fetch(Zc, base, t0 + tb + k, st, 15); uo[k] = ep_fetch(Zc, base, t0 + tb + k - w + 1, st, 15); }
#pragma unroll
                for (int k = 0; k < 8; ++k) { const int t = t0 + tb + k; s += un[k];
                    const float cnt = isP ? (float)((t + 1) < w ? (t + 1) : w) : (float)w; const f32x4 d = s / cnt - un[k];
                    v2u o; o.x = pk2(d[0], d[1]); o.y = pk2(d[2], d[3]); *(v2u*)(Dp + (size_t)(base + t) * 1024 + c) = o;
                    if (isP) { if (t >= SEQ - 15) *(f32x4*)(o_poolp + ((size_t)b * 15 + (t - (SEQ - 15))) * 1024 + c) = un[k]; }
                    else { *(f32x4*)(o_pools + ((size_t)b * 15 + 7 + t) * 1024 + c) = un[k];
                           if (t < 7) *(f32x4*)(o_pools + ((size_t)b * 15 + t) * 1024 + c) = *(const f32x4*)(st + (size_t)(8 + t) * 1024); }
                    s -= uo[k]; } }
        } else {
            const int c = (q - 256) * 4; const bf16* Zc = Z + 1024 + c; const float* st = isP ? nullptr : sconv + (size_t)b * 3 * 1024 + c;
            const f32x4 w0 = *(const f32x4*)(cw + c), w1 = *(const f32x4*)(cw + 1024 + c), w2 = *(const f32x4*)(cw + 2048 + c), w3 = *(const f32x4*)(cw + 3072 + c), bias = *(const f32x4*)(cb + c);
            if (isP) { const bf16* Zr = Zc + (size_t)(base + t0) * 2048; bf16* Cr = Cv + (size_t)(base + t0) * 1024 + c; v2u raw[35]; const bool first = t0 == 0;
#pragma unroll
                for (int i = 0; i < 35; ++i) raw[i] = (i < 3 && first) ? (v2u){0u, 0u} : *(const v2u*)(Zr + (ptrdiff_t)(i - 3) * 2048);
#pragma unroll
                for (int k = 0; k < 32; ++k) { const f32x4 un = ep_cvt(raw[k + 3]); const f32x4 acc = bias + ep_cvt(raw[k]) * w0 + ep_cvt(raw[k + 1]) * w1 + ep_cvt(raw[k + 2]) * w2 + un * w3;
                    v2u o; o.x = pk2(acc[0], acc[1]); o.y = pk2(acc[2], acc[3]); *(v2u*)(Cr + (size_t)k * 1024) = o;
                    if (t0 + k >= SEQ - 3) *(f32x4*)(o_convp + ((size_t)b * 3 + (t0 + k - (SEQ - 3))) * 1024 + c) = un; }
                continue; }
            else { const bf16* Zr = Zc + (size_t)base * 2048; bf16* Cr = Cv + (size_t)base * 1024 + c; v2u raw[8];
                f32x4 p3 = *(const f32x4*)(st), p2 = *(const f32x4*)(st + 1024), p1 = *(const f32x4*)(st + 2048);
#pragma unroll
                for (int i = 0; i < 8; ++i) raw[i] = *(const v2u*)(Zr + (size_t)i * 2048);
#pragma unroll
                for (int k = 0; k < 8; ++k) { const f32x4 un = ep_cvt(raw[k]); const f32x4 acc = bias + p3 * w0 + p2 * w1 + p1 * w2 + un * w3;
                    v2u o; o.x = pk2(acc[0], acc[1]); o.y = pk2(acc[2], acc[3]); *(v2u*)(Cr + (size_t)k * 1024) = o;
                    if (k >= DSQ - 3) *(f32x4*)(o_convs + ((size_t)b * 3 + (k - (DSQ - 3))) * 1024 + c) = un;
                    p3 = p2; p2 = p1; p1 = un; }
                continue; }
            f32x4 p3 = ep_fetch(Zc, base, t0 - 3, st, 3), p2 = ep_fetch(Zc, base, t0 - 2, st, 3), p1 = ep_fetch(Zc, base, t0 - 1, st, 3);
            for (int tb = 0; tb < nrun; tb += 8) { f32x4 un[8];
#pragma unroll
                for (int k = 0; k < 8; ++k) un[k] = ep_fetch(Zc, base, t0 + tb + k, st, 3);
#pragma unroll
                for (int k = 0; k < 8; ++k) { const int t = t0 + tb + k; const f32x4 acc = bias + p3 * w0 + p2 * w1 + p1 * w2 + un[k] * w3;
                    v2u o; o.x = pk2(acc[0], acc[1]); o.y = pk2(acc[2], acc[3]); *(v2u*)(Cv + (size_t)(base + t) * 1024 + c) = o;
                    if (isP) { if (t >= SEQ - 3) *(f32x4*)(o_convp + ((size_t)b * 3 + (t - (SEQ - 3))) * 1024 + c) = un[k]; }
                    else if (t >= DSQ - 3) *(f32x4*)(o_convs + ((size_t)b * 3 + (t - (DSQ - 3))) * 1024 + c) = un[k];
                    p3 = p2; p2 = p1; p1 = un[k]; } }
        }
    }
}

__device__ __forceinline__ void even_scan(const Args& a, int e, LAS unsigned char* lds) {
    int tid = threadIdx.x; asm volatile("" : "+v"(tid));
    unsigned char* ws = a.ws; const unsigned* GAB = (const unsigned*)(ws + WS_GA); const bf16* UG = (const bf16*)(ws + WS_UGB); bf16* Y2 = (bf16*)(ws + WS_Y2);
    float* o_hp = a.out + O_HP + (size_t)e * NBP * 1024; float* o_hs = a.out + O_HS + (size_t)e * NBS * 1024; const float* h0s = a.in[4] + (size_t)e * NBS * 1024;
    const int G = gridDim.x; LAS float* car = (LAS float*)(lds + RING_OFF);
    const int ck = tid >> 4, cl = tid & 15;
    for (int it = blockIdx.x; it < NBP * 64; it += G) { const int b = it >> 6, cb = it & 63, r0 = b * SEQ + ck * 64;
        const size_t ob = ((size_t)cb * M + r0) * 16 + cl; const unsigned* pg = GAB + ob; const bf16* pu = UG + ob;
        float av[64], bv[64];
#pragma unroll
        for (int t = 0; t < 64; ++t) { const unsigned w = pg[t * 16]; av[t] = bf_lo(w); bv[t] = bf_hi(w); }
        bf16 ugn[16];
#pragma unroll
        for (int k = 0; k < 16; ++k) ugn[k] = pu[k * 16];
        float A = 1.f, h = 0.f;
#pragma unroll
        for (int t = 0; t < 64; ++t) { av[t] = __expf(av[t]); h = av[t] * h + bv[t]; A *= av[t]; }
        car[(ck * 2 + 0) * 16 + cl] = A; car[(ck * 2 + 1) * 16 + cl] = h;
        LDS_WAIT(); __syncthreads();
        float c = 0.f;
#pragma unroll 8
        for (int j = 0; j < 32; ++j) { const float ca = car[(j * 2 + 0) * 16 + cl], ch = car[(j * 2 + 1) * 16 + cl]; c = j < ck ? ca * c + ch : c; }
        h = c; bf16* py = Y2 + (size_t)r0 * D + 1024 + cb * 16 + cl;
#pragma unroll
        for (int tb = 0; tb < 64; tb += 16) { float ug[16];
#pragma unroll
            for (int k = 0; k < 16; ++k) ug[k] = bf_lo((unsigned)ugn[k]);
            if (tb + 16 < 64) {
#pragma unroll
                for (int k = 0; k < 16; ++k) ugn[k] = pu[(tb + 16 + k) * 16]; }
#pragma unroll
            for (int k = 0; k < 16; ++k) { h = av[tb + k] * h + bv[tb + k]; *py = (bf16)pk2(h * gelu_tanh(ug[k]), 0.f); py += D; }
            asm volatile("" ::: "memory"); }
        if (ck == 31) o_hp[(size_t)b * 1024 + cb * 16 + cl] = h;
        __syncthreads(); }
    for (int idx = blockIdx.x * NTHR + tid; idx < NBS * 1024; idx += G * NTHR) { const int b = idx >> 10, ch = idx & 1023; float h = h0s[idx];
        const size_t ob = ((size_t)(ch >> 4) * M + MP + b * DSQ) * 16 + (ch & 15);
        unsigned gw[8]; float ug[8];
#pragma unroll
        for (int t = 0; t < DSQ; ++t) { gw[t] = GAB[ob + t * 16]; ug[t] = bf_lo((unsigned)UG[ob + t * 16]); }
#pragma unroll
        for (int t = 0; t < DSQ; ++t) { const int row = MP + b * DSQ + t; h = __expf(bf_lo(gw[t])) * h + bf_hi(gw[t]); Y2[(size_t)row * D + 1024 + ch] = (bf16)pk2(h * gelu_tanh(ug[t]), 0.f); }
        o_hs[idx] = h; }
}

constexpr int S5_BU_STRIDE = 132, S5_XS_STRIDE = 68, S5_WAVE_LDS = 16 * S5_BU_STRIDE * 4 + 16 * S5_XS_STRIDE * 4;
typedef short s5_bf16x8 __attribute__((ext_vector_type(8)));
__device__ __forceinline__ s5_bf16x8 s5_pack8(const float (&v)[8]) { v4u w; w.x = pk2(v[0], v[1]); w.y = pk2(v[2], v[3]); w.z = pk2(v[4], v[5]); w.w = pk2(v[6], v[7]); return __builtin_bit_cast(s5_bf16x8, w); }
__device__ __forceinline__ void s5_setup(const Args& a, int o, int g, int lane, s5_bf16x8 (&bbf)[8], s5_bf16x8 (&cmf)[4], s5_bf16x8& dmf, float (&gm8)[8], float& ar, float& ai) {
    unsigned char* ws = a.ws; const int og = o * 128 + g, tl = lane & 15, q = lane >> 4;
    const float* BB = (const float*)(ws + WS_BB);
#pragma unroll
    for (int nb = 0; nb < 8; ++nb) { float v[8];
#pragma unroll
        for (int j = 0; j < 8; ++j) v[j] = 0.f;
        if (q < 2) { const int pp = nb * 16 + tl; const float* s = BB + ((size_t)og * 64 + (pp >> 1)) * 32 + (pp & 1) * 16 + 8 * q; const f32x4 v0 = *(const f32x4*)s, v1 = *(const f32x4*)(s + 4);
            v[0] = v0[0]; v[1] = v0[1]; v[2] = v0[2]; v[3] = v0[3]; v[4] = v1[0]; v[5] = v1[1]; v[6] = v1[2]; v[7] = v1[3]; }
        bbf[nb] = s5_pack8(v); }
#pragma unroll
    for (int kb = 0; kb < 4; ++kb) { const size_t ci = ((size_t)og * 16 + tl) * 64 + kb * 16 + 4 * q; const f32x4 cr = *(const f32x4*)(a.in[30] + ci), cm = *(const f32x4*)(a.in[31] + ci);
        const float v[8] = {cr[0], -cm[0], cr[1], -cm[1], cr[2], -cm[2], cr[3], -cm[3]}; cmf[kb] = s5_pack8(v); }
    { const float dv = a.in[32][(size_t)o * D + g * 16 + tl]; float v[8];
#pragma unroll
      for (int j = 0; j < 8; ++j) v[j] = (q < 2 && 8 * q + j == tl) ? dv : 0.f;
      dmf = s5_pack8(v); }
#pragma unroll
    for (int j = 0; j < 8; ++j) gm8[j] = (q < 2) ? a.in[10][(size_t)(2 * o + 1) * D + g * 16 + 8 * q + j] : 0.f;
    const float* AB = (const float*)(ws + WS_AB) + ((size_t)og * 64 + lane) * 2; ar = AB[0]; ai = AB[1];
}
template <int MODE>
__device__ __forceinline__ void s5_run(const Args& a, int row0, int L, int g, const pg8::rs_t* rs, LAS unsigned char* wl, int lane,
                                       const s5_bf16x8 (&bbf)[8], const s5_bf16x8 (&cmf)[4], const s5_bf16x8& dmf, const float (&gm8)[8], float ar, float ai, float& xr, float& xi,
                                       const float* sin_re, const float* sin_im, float* sout_re, float* sout_im) {
    unsigned char* ws = a.ws; const bf16* X = (const bf16*)(ws + WS_XB); bf16* Y2 = (bf16*)(ws + WS_Y2);
    const int tl = lane & 15, q = lane >> 4; constexpr bool FULL = MODE != 0; constexpr size_t SSEQ = (size_t)NGRP * NST;
    LAS float* Bu = (LAS float*)wl; LAS unsigned* Xs = (LAS unsigned*)(wl + 16 * S5_BU_STRIDE * 4);
    const f32x4 zero4 = (f32x4){0.f, 0.f, 0.f, 0.f};
    const int nblk = (L + 15) >> 4;
    v4u xw[3]; float rv[3]; const v4u zw = (v4u){0u, 0u, 0u, 0u};
#pragma unroll
    for (int k = 0; k < 3; ++k) { xw[k] = zw; rv[k] = 1.f;
        if (q < 2 && 16 * k + tl < L) { xw[k] = *(const v4u*)(X + (size_t)(row0 + 16 * k + tl) * D + g * 16 + 8 * q); rv[k] = pg8::rs_get(rs[row0 + 16 * k + tl]); } }
    float n0r = 0.f, n0i = 0.f, n1r = 0.f, n1i = 0.f;
    if (MODE == 2) { n0r = sin_re[lane]; n0i = sin_im[lane]; n1r = sin_re[SSEQ + lane]; n1i = sin_im[SSEQ + lane]; }
#define S5_NEXT_BU(TN) do { \
        { const float rstd = pg8::rstd_of(rv[0], INV_D); const v4u x0 = xw[0]; const float v[8] = {bf_lo(x0.x) * rstd * gm8[0], bf_hi(x0.x) * rstd * gm8[1], bf_lo(x0.y) * rstd * gm8[2], bf_hi(x0.y) * rstd * gm8[3], bf_lo(x0.z) * rstd * gm8[4], bf_hi(x0.z) * rstd * gm8[5], bf_lo(x0.w) * rstd * gm8[6], bf_hi(x0.w) * rstd * gm8[7]}; \
          ufn = s5_pack8(v); } \
        xw[0] = xw[1]; rv[0] = rv[1]; xw[1] = xw[2]; rv[1] = rv[2]; xw[2] = zw; rv[2] = 1.f; \
        if (q < 2 && (TN) + 48 + tl < L) { xw[2] = *(const v4u*)(X + (size_t)(row0 + (TN) + 48 + tl) * D + g * 16 + 8 * q); rv[2] = pg8::rs_get(rs[row0 + (TN) + 48 + tl]); } \
        _Pragma("unroll") \
        for (int nb = 0; nb < 8; ++nb) { const f32x4 d = __builtin_amdgcn_mfma_f32_16x16x32_bf16(bbf[nb], ufn, zero4, 0, 0, 0); *(LAS f32x4*)(Bu + tl * S5_BU_STRIDE + nb * 16 + 4 * q) = d; }     \
    } while (0)
    s5_bf16x8 ufn;
    S5_NEXT_BU(0);
    for (int blk = 0; blk < nblk; ++blk) {
        const int t0 = blk * 16, nst = (L - t0) < 16 ? (L - t0) : 16;
        float s0r = 0.f, s0i = 0.f, s1r = 0.f, s1i = 0.f;
        if (MODE == 2) { s0r = n0r; s0i = n0i; s1r = n1r; s1i = n1i;
            if (blk + 1 < nblk) { n0r = sin_re[(size_t)(2 * blk + 2) * SSEQ + lane]; n0i = sin_im[(size_t)(2 * blk + 2) * SSEQ + lane]; n1r = sin_re[(size_t)(2 * blk + 3) * SSEQ + lane]; n1i = sin_im[(size_t)(2 * blk + 3) * SSEQ + lane]; } }
        const s5_bf16x8 uf = ufn;
        LDS_WAIT(); asm volatile("" ::: "memory");
        typedef float f32x2v __attribute__((ext_vector_type(2)));
        f32x2v bw[16];
#pragma unroll
        for (int t = 0; t < 16; ++t) bw[t] = *(const LAS f32x2v*)(Bu + t * S5_BU_STRIDE + 2 * lane);
        if (blk + 1 < nblk) S5_NEXT_BU(t0 + 16);
        f32x2v xs = (f32x2v){xr, xi}; const f32x2v aar = (f32x2v){ar, ar}, aai = (f32x2v){-ai, ai};
        if (MODE != 2 && nst == 16) {
#pragma unroll
            for (int t = 0; t < 16; ++t) { const f32x2v bb = bw[t]; xs = aar * xs + (aai * (f32x2v){xs.y, xs.x} + bb);
                if (FULL) Xs[t * S5_XS_STRIDE + lane] = pk2(xs.x, xs.y); } }
        else {
#pragma unroll
            for (int t = 0; t < 16; ++t) {
                if (MODE == 2) { if (t == 0) xs = (f32x2v){s0r, s0i}; if (t == 8) xs = (f32x2v){s1r, s1i}; }
                const f32x2v bb = bw[t]; const f32x2v nx = aar * xs + (aai * (f32x2v){xs.y, xs.x} + bb);
                if (t < nst) xs = nx;
                if (FULL) Xs[t * S5_XS_STRIDE + lane] = pk2(xs.x, xs.y);
                if (MODE == 2) { if (t == 7) { sout_re[(size_t)(2 * blk) * SSEQ + lane] = xs.x; sout_im[(size_t)(2 * blk) * SSEQ + lane] = xs.y; }
                                 if (t == 15) { sout_re[(size_t)(2 * blk + 1) * SSEQ + lane] = xs.x; sout_im[(size_t)(2 * blk + 1) * SSEQ + lane] = xs.y; } } } }
        xr = xs.x; xi = xs.y;
        LDS_WAIT(); asm volatile("" ::: "memory");
        if (FULL) {
            f32x4 y = zero4;
#pragma unroll
            for (int kb = 0; kb < 4; ++kb) { const s5_bf16x8 xf = *(const LAS s5_bf16x8*)(Xs + tl * S5_XS_STRIDE + kb * 16 + 4 * q); y = __builtin_amdgcn_mfma_f32_16x16x32_bf16(cmf[kb], xf, y, 0, 0, 0); }
            y = __builtin_amdgcn_mfma_f32_16x16x32_bf16(dmf, uf, y, 0, 0, 0);
            if (tl < nst) { v2u w; w.x = pk2(gelu_tanh(y[0]), gelu_tanh(y[1])); w.y = pk2(gelu_tanh(y[2]), gelu_tanh(y[3])); *(v2u*)(Y2 + (size_t)(row0 + t0 + tl) * D + g * 16 + 4 * q) = w; }
            asm volatile("" ::: "memory"); }
    }
}
#undef S5_NEXT_BU
__device__ __forceinline__ void s5_pass1(const Args& a, int o, int g, int row0, const pg8::rs_t* rs, LAS unsigned char* wl, int lane, float ar, float ai, float& xr, float& xi) {
    unsigned char* ws = a.ws; const bf16* X = (const bf16*)(ws + WS_XB); const int tl = lane & 15, q = lane >> 4, og = o * 128 + g;
    const bf16* W1 = (const bf16*)(ws + WS_W1) + (size_t)og * 128 * 256; LAS float* P1 = (LAS float*)wl;
    typedef float f32x2v __attribute__((ext_vector_type(2)));
    float gmb[8];
#pragma unroll
    for (int j = 0; j < 8; ++j) gmb[j] = a.in[10][(size_t)(2 * o + 1) * D + g * 16 + 8 * (q & 1) + j];
    v4u xw[8]; float rv[8];
#pragma unroll
    for (int ks = 0; ks < 8; ++ks) { const int row = row0 + 16 * tl + 2 * ks + (q >> 1); xw[ks] = *(const v4u*)(X + (size_t)row * D + g * 16 + 8 * (q & 1)); rv[ks] = pg8::rs_get(rs[row]); }
    s5_bf16x8 uf[8];
#pragma unroll
    for (int ks = 0; ks < 8; ++ks) { const float rstd = pg8::rstd_of(rv[ks], INV_D); const v4u x0 = xw[ks];
        const float v[8] = {bf_lo(x0.x) * rstd * gmb[0], bf_hi(x0.x) * rstd * gmb[1], bf_lo(x0.y) * rstd * gmb[2], bf_hi(x0.y) * rstd * gmb[3], bf_lo(x0.z) * rstd * gmb[4], bf_hi(x0.z) * rstd * gmb[5], bf_lo(x0.w) * rstd * gmb[6], bf_hi(x0.w) * rstd * gmb[7]};
        uf[ks] = s5_pack8(v); }
    for (int qt = 0; qt < 4; ++qt) {
        const bf16* W1q = W1 + (size_t)(qt * 2) * 8 * 64 * 8 + (size_t)lane * 8;
        s5_bf16x8 af[2][8];
#pragma unroll
        for (int mb = 0; mb < 2; ++mb)
#pragma unroll
            for (int ks = 0; ks < 8; ++ks) af[mb][ks] = *(const s5_bf16x8*)(W1q + (size_t)(mb * 8 + ks) * 512);
        f32x4 acc[2] = {(f32x4){0.f, 0.f, 0.f, 0.f}, (f32x4){0.f, 0.f, 0.f, 0.f}};
#pragma unroll
        for (int ks = 0; ks < 8; ++ks)
#pragma unroll
            for (int mb = 0; mb < 2; ++mb) acc[mb] = __builtin_amdgcn_mfma_f32_16x16x32_bf16(af[mb][ks], uf[ks], acc[mb], 0, 0, 0);
#pragma unroll
        for (int mb = 0; mb < 2; ++mb) *(LAS f32x4*)(P1 + tl * S5_BU_STRIDE + qt * 32 + mb * 16 + 4 * q) = acc[mb];
        asm volatile("" ::: "memory"); }
    LDS_WAIT(); asm volatile("" ::: "memory");
    float pr = ar, pi = ai;
#pragma unroll
    for (int k = 0; k < 4; ++k) { const float nr = pr * pr - pi * pi, ni = 2.0f * pr * pi; pr = nr; pi = ni; }
    f32x2v e[16];
#pragma unroll
    for (int b = 0; b < 16; ++b) e[b] = *(const LAS f32x2v*)(P1 + b * S5_BU_STRIDE + 2 * lane);
    f32x2v xs = (f32x2v){0.f, 0.f}; const f32x2v ppr = (f32x2v){pr, pr}, ppi = (f32x2v){-pi, pi};
#pragma unroll
    for (int b = 0; b < 16; ++b) xs = ppr * xs + (ppi * (f32x2v){xs.y, xs.x} + e[b]);
    xr = xs.x; xi = xs.y;
    LDS_WAIT(); asm volatile("" ::: "memory");
}
__device__ __forceinline__ void s5_phase(const Args& a, int o, const pg8::rs_t* rs, LAS unsigned char* lds) {
    int tid = threadIdx.x; asm volatile("" : "+v"(tid)); const int lane = tid & 63, wave = __builtin_amdgcn_readfirstlane(tid >> 6);
    const int G = gridDim.x; LAS unsigned char* wl = lds + RING_OFF + wave * S5_WAVE_LDS; LAS float* ends = (LAS float*)(lds + RING_OFF + NWAVES * S5_WAVE_LDS);
    s5_bf16x8 bbf[8], cmf[4], dmf; float gm8[8], ar, ai;
    for (int it = blockIdx.x; it < NBP * NGRP; it += G) {
        int b = it >> 7, g = it & 127;
        if (G == 256) { const int c = it & 255, k = it >> 8, x = c & 7, j = c >> 3; g = x * 16 + (j & 15); b = 2 * k + (j >> 4); }
        const int row0 = b * SEQ + wave * 256;
        { const float* AB = (const float*)(a.ws + WS_AB) + ((size_t)(o * 128 + g) * 64 + lane) * 2; ar = AB[0]; ai = AB[1]; }
        float xr = 0.f, xi = 0.f;
        s5_pass1(a, o, g, row0, rs, wl, lane, ar, ai, xr, xi);
        asm volatile("" ::: "memory");
        s5_setup(a, o, g, lane, bbf, cmf, dmf, gm8, ar, ai);
        ends[(wave * 2 + 0) * 64 + lane] = xr; ends[(wave * 2 + 1) * 64 + lane] = xi;
        float pr = ar, pi = ai;
#pragma unroll
        for (int k = 0; k < 8; ++k) { const float nr = pr * pr - pi * pi, ni = 2.0f * pr * pi; pr = nr; pi = ni; }
        LDS_WAIT(); __syncthreads();
        xr = 0.f; xi = 0.f;
        for (int j = 0; j < wave; ++j) { const float er = ends[(j * 2 + 0) * 64 + lane], ei = ends[(j * 2 + 1) * 64 + lane]; const float nr = pr * xr - pi * xi + er, ni = pr * xi + pi * xr + ei; xr = nr; xi = ni; }
        s5_run<1>(a, row0, 256, g, rs, wl, lane, bbf, cmf, dmf, gm8, ar, ai, xr, xi, nullptr, nullptr, nullptr, nullptr);
        if (wave == NWAVES - 1) { const size_t so = ((size_t)(o * NBP + b) * NGRP + g) * NST; a.out[O_REP + so + lane] = xr; a.out[O_IMP + so + lane] = xi; }
        __syncthreads(); }
    for (int it = blockIdx.x * NWAVES + wave; it < NGRP * (NBS / 8); it += G * NWAVES) { const int g = it & 127, b0 = (it >> 7) * 8; const size_t so = ((size_t)(o * NBS + b0) * NGRP + g) * NST;
        s5_setup(a, o, g, lane, bbf, cmf, dmf, gm8, ar, ai);
        float xr = 0.f, xi = 0.f;
        s5_run<2>(a, MP + b0 * DSQ, 8 * DSQ, g, rs, wl, lane, bbf, cmf, dmf, gm8, ar, ai, xr, xi, a.in[5] + so, a.in[6] + so, a.out + O_RES + so, a.out + O_IMS + so); }
}

template <int MODE>
__device__ __forceinline__ void splitk_fixup(const Args& a, const pg8::Gemm& g, int L0, int ntail, int nsplit, const pg8::rs_t* rs, pg8::rs_t* rsn, float alpha) {
    int tid = threadIdx.x; asm volatile("" : "+v"(tid)); const int lane = tid & 63, wave = __builtin_amdgcn_readfirstlane(tid >> 6);
    const int G = gridDim.x, gw = blockIdx.x * NWAVES + wave, NGW = G * NWAVES;
    bf16* Xb = (bf16*)(a.ws + WS_XB); bf16* Hb = (bf16*)(a.ws + WS_H); const bf16* P = (const bf16*)(a.ws + WS_PART);
    pg8::StaticOrder so; so.init(g, G, 0);
    if (MODE == 0 && nsplit == 8) {
        const int total = ntail * 256;
        for (int it0 = gw; it0 < total; it0 += 4 * NGW) { v2u p[4][8]; v2u xo[4]; size_t off[4]; int row[4]; bool ok[4];
#pragma unroll
            for (int k = 0; k < 4; ++k) { const int it = it0 + k * NGW; ok[k] = it < total; const int itc = ok[k] ? it : it0; const int ti = itc >> 8, r = itc & 255; pg8::Unit u; so.tile_of(L0 + ti, u);
                row[k] = u.pm * 256 + r; off[k] = (size_t)row[k] * D + u.pn * 256 + 4 * lane; xo[k] = *(const v2u*)(Xb + off[k]);
#pragma unroll
                for (int sp = 0; sp < 8; ++sp) p[k][sp] = *(const v2u*)(P + (size_t)(sp * ntail + ti) * 65536 + r * 256 + 4 * lane); }
#pragma unroll
            for (int k = 0; k < 4; ++k) { float s0 = 0.f, s1 = 0.f, s2 = 0.f, s3 = 0.f;
#pragma unroll
                for (int sp = 0; sp < 8; ++sp) { s0 += bf_lo(p[k][sp].x); s1 += bf_hi(p[k][sp].x); s2 += bf_lo(p[k][sp].y); s3 += bf_hi(p[k][sp].y); }
                v2u w; w.x = pk2(bf_lo(xo[k].x) + s0 * alpha, bf_hi(xo[k].x) + s1 * alpha); w.y = pk2(bf_lo(xo[k].y) + s2 * alpha, bf_hi(xo[k].y) + s3 * alpha);
                const float v0 = bf_lo(w.x), v1 = bf_hi(w.x), v2 = bf_lo(w.y), v3 = bf_hi(w.y); const float ss = wave_sum((v0 * v0 + v1 * v1) + (v2 * v2 + v3 * v3));
                if (ok[k]) { *(v2u*)(Xb + off[k]) = w; if (lane == 0) pg8::rs_add(rsn + row[k], ss); } } }
        return; }
    for (int it = gw; it < ntail * 256; it += NGW) { const int ti = it >> 8, r = it & 255; pg8::Unit u; so.tile_of(L0 + ti, u); const int row = u.pm * 256 + r;
        if (MODE == 0) { const int col = u.pn * 256 + 4 * lane; float s0 = 0.f, s1 = 0.f, s2 = 0.f, s3 = 0.f;
            for (int sp = 0; sp < nsplit; ++sp) { const v2u p = *(const v2u*)(P + (size_t)(sp * ntail + ti) * 65536 + r * 256 + 4 * lane); s0 += bf_lo(p.x); s1 += bf_hi(p.x); s2 += bf_lo(p.y); s3 += bf_hi(p.y); }
            const size_t off = (size_t)row * D + col; const v2u xo = *(const v2u*)(Xb + off);
            v2u w; w.x = pk2(bf_lo(xo.x) + s0 * alpha, bf_hi(xo.x) + s1 * alpha); w.y = pk2(bf_lo(xo.y) + s2 * alpha, bf_hi(xo.y) + s3 * alpha); *(v2u*)(Xb + off) = w;
            const float v0 = bf_lo(w.x), v1 = bf_hi(w.x), v2 = bf_lo(w.y), v3 = bf_hi(w.y);
            const float ss = wave_sum((v0 * v0 + v1 * v1) + (v2 * v2 + v3 * v3)); if (lane == 0) pg8::rs_add(rsn + row, ss); }
        else { float a0 = 0.f, a1 = 0.f, b0 = 0.f, b1 = 0.f;
            for (int sp = 0; sp < nsplit; ++sp) { const bf16* p = P + (size_t)(sp * ntail + ti) * 65536 + r * 256 + 2 * lane; const unsigned p1 = *(const unsigned*)p, p2 = *(const unsigned*)(p + 128); a0 += bf_lo(p1); a1 += bf_hi(p1); b0 += bf_lo(p2); b1 += bf_hi(p2); }
            if (MODE == 1) { const float rstd = pg8::rstd_of(pg8::rs_get(rs[row]), INV_D); const float g0 = a0 * rstd, g1 = a1 * rstd;
                *(unsigned*)(Hb + (size_t)row * DFF + u.pn * 128 + 2 * lane) = pk2(g0 * pg8::sigmoidf_fast(g0) * (b0 * rstd), g1 * pg8::sigmoidf_fast(g1) * (b1 * rstd)); }
            else { const size_t off = (size_t)row * D + u.pn * 128 + 2 * lane; const unsigned xo = *(const unsigned*)(Xb + off);
                const unsigned w = pk2(bf_lo(xo) + a0 * pg8::sigmoidf_fast(b0), bf_hi(xo) + a1 * pg8::sigmoidf_fast(b1)); *(unsigned*)(Xb + off) = w;
                const float v0 = bf_lo(w), v1 = bf_hi(w); const float ss = wave_sum(v0 * v0 + v1 * v1); if (lane == 0) pg8::rs_add(rsn + row, ss); } }
    }
}

__device__ __forceinline__ void final_norm(const Args& a, const pg8::rs_t* rs) {
    int tid = threadIdx.x; asm volatile("" : "+v"(tid)); const int lane = tid & 63, wave = __builtin_amdgcn_readfirstlane(tid >> 6);
    const bf16* Xb = (const bf16*)(a.ws + WS_XB); const float* gn = a.in[34]; const int gw = blockIdx.x * NWAVES + wave, NGW = gridDim.x * NWAVES;
    for (int m = gw; m < M; m += NGW) { const float rstd = pg8::rstd_of(pg8::rs_get(rs[m]), INV_D); float* dst = (m < MP) ? a.out + O_YP + (size_t)m * D : a.out + O_YS + (size_t)(m - MP) * D;
#pragma unroll
        for (int q = 0; q < 8; ++q) { const v2u x = *((const v2u*)(Xb + (size_t)m * D) + lane + 64 * q); const f32x4 gq = *((const f32x4*)gn + lane + 64 * q);
            *((f32x4*)dst + lane + 64 * q) = (f32x4){bf_lo(x.x) * rstd * gq[0], bf_hi(x.x) * rstd * gq[1], bf_lo(x.y) * rstd * gq[2], bf_hi(x.y) * rstd * gq[3]}; } }
}

#ifndef PH_MASK
#define PH_MASK 0xFFF
#endif
#ifndef MK_PER_PHASE
#define MK_PER_PHASE 0
#endif
__global__ void __launch_bounds__(NTHR, 2) mk_fwd(Args a) {
    extern __shared__ __attribute__((aligned(16))) unsigned char lds_raw[];
    LAS unsigned char* lds = (LAS unsigned char*)lds_raw;
    const int tid = threadIdx.x, G = gridDim.x;
    volatile LAS unsigned* MISC = (volatile LAS unsigned*)(lds + MISC_OFF);
    for (int u = tid; u < (LDS_BYTES - LDSCTL_OFF) / 4; u += NTHR) ((LAS unsigned*)(lds + LDSCTL_OFF))[u] = 0u;
    __syncthreads();
    unsigned char* ws = a.ws;
    unsigned* ctl = (unsigned*)(ws + WS_CTL);
    const int lo = a.lo, hi = a.hi;
    XcdBarrier bar; bar.bar = ctl + CW_BAR; bar.x = 0; bar.st = nullptr;
    if (hi - lo > 1) bar = xcd_barrier_post(ctl + CW_BAR, MISC + 8);
    bf16* Xb = (bf16*)(ws + WS_XB); pg8::rs_t* RS = (pg8::rs_t*)(ws + WS_RS); bf16* Hb = (bf16*)(ws + WS_H);
    bf16* Z = (bf16*)(ws + WS_Z); bf16* Dp = (bf16*)(ws + WS_DP); bf16* Cv = (bf16*)(ws + WS_CV);
    unsigned* GAB = (unsigned*)(ws + WS_GA); bf16* Y2 = (bf16*)(ws + WS_Y2);
    int pc = 0;
#define ON() (pc >= lo && pc < hi)
#define SEAM() do { if (pc >= lo && pc + 1 < hi) xcd_barrier(bar); ++pc; } while (0)
#define GEMM_PHASE(EPI, g, E) do { pg8::StaticOrder S_; S_.init(g, G, (int)blockIdx.x); pg8::gemm_phase<EPI, pg8::StaticOrder, true, true>(lds + RING_OFF, g, S_, E); } while (0)

#define GEMM_TAIL_PHASE(EPI, MODE, g, E, NFULL, rs_, rsn_, alpha_) do { \
        const int nun_ = ((g).M / 256) * ((g).N / 256), ntail_ = nun_ - (NFULL) * G, npairs_ = (g).K / 128; \
        const bool split_ = ntail_ > 0 && ntail_ <= G; int nsplit_ = split_ ? G / ntail_ : 1; if (nsplit_ > npairs_ / 2) nsplit_ = npairs_ / 2; \
        if (ON()) { { pg8::StaticOrder S_; S_.init(g, G, (int)blockIdx.x, split_ ? (NFULL) : (1 << 30)); pg8::gemm_phase<EPI, pg8::StaticOrder, true, true>(lds + RING_OFF, g, S_, E); } \
            if (split_) { const pg8::EpiPartial EP_{(bf16*)(ws + WS_PART)}; pg8::SplitTailOrder T_; T_.init(g, G, (int)blockIdx.x, (NFULL) * G, ntail_, nsplit_); pg8::gemm_phase<pg8::EpiPartial, pg8::SplitTailOrder, true, true>(lds + RING_OFF, g, T_, EP_); } } \
        SEAM(); \
        if (split_) { if (ON()) splitk_fixup<MODE>(a, g, (NFULL) * G, ntail_, nsplit_, rs_, rsn_, alpha_); \
            SEAM(); } } while (0)

    if (ON()) if constexpr ((PH_MASK >> 0) & 1) { p0_prologue(a, lds); }
    SEAM();
    int fi = 0;
    for (int l = 0; l <= 4; ++l) {
        const int nrep = (l == 0 || l == 4) ? 1 : 2;
        for (int rep = 0; rep < nrep; ++rep, ++fi) {
            const int xv = fi + ((fi + 1) >> 1);
            const int dk = (G != 256 || fi == 0) ? 0 : ((fi & 1) == 0 ? 1 : ((fi & 3) == 1 ? 2 : 3));
            const bool defer_this = (G == 256) && (fi == 1 || fi == 3 || fi == 5);
            { const pg8::Gemm g{Xb, (const bf16*)(ws + WS_FIN + (size_t)fi * SZ_FIN), M, NFF, D, D, 0, 0}; const pg8::EpiSwiglu E{Hb, DFF, RS + (size_t)xv * M, INV_D};
              const int GG = (G == 256) ? 224 : G, nrounds = ((M / 256) * (NFF / 256) + GG - 1) / GG;
              {
                if (ON()) if constexpr ((PH_MASK >> 1) & 1) {
                    unsigned* dflag = ctl + CW_FLAG + 64 * fi;
                    if (GG == G && fi + 1 < 8) { int tid3 = threadIdx.x; asm volatile("" : "+v"(tid3)); const int w3 = __builtin_amdgcn_readfirstlane(tid3 >> 6); cvt_stage(a, fi + 1, (int)blockIdx.x * NWAVES + w3, G * NWAVES, tid3 & 63, (LAS unsigned*)(lds + RING_OFF + w3 * 9216)); __syncthreads(); }
                    if ((int)blockIdx.x < GG) { pg8::SeqOrder S_; S_.init(g, MP / 256, GG, (int)blockIdx.x, 0, nrounds); if (dk) { S_.flag = dflag; S_.target = (unsigned)(G - GG); } pg8::gemm_phase<pg8::EpiSwiglu, pg8::SeqOrder, true, true>(lds + RING_OFF, g, S_, E); }
                    else {
                      if (dk) { const int c2 = (int)blockIdx.x - GG, lm = (fi - 1) >> 1;
                        if (dk == 3) { const pg8::Gemm g2{Y2, (const bf16*)(ws + WS_GLU + (size_t)(lm >> 1) * SZ_GLU), M, 4096, D, D, 0, 0}; const pg8::EpiGlu E2{Xb, RS + (size_t)xv * M};
                            const pg8::FewUnitsOrder O_{MP / 256, MS / 256, 16, 2 * c2, 2, D}; pg8::gemm_phase<pg8::EpiGlu, pg8::FewUnitsOrder, true, true>(lds + RING_OFF, g2, O_, E2); }
                        else { const pg8::Gemm g2{dk == 1 ? Hb : Y2, dk == 1 ? (const bf16*)(ws + WS_FOUT + (size_t)(fi - 1) * SZ_FOUT) : (const bf16*)(ws + WS_EOUT + (size_t)(lm >> 1) * SZ_EOUT), M, D, dk == 1 ? DFF : D, dk == 1 ? DFF : D, 0, 0};
                            const pg8::EpiResid E2{Xb, RS + (size_t)xv * M, dk == 1 ? 0.5f : 1.0f};
                            const pg8::FewUnitsOrder O_{MP / 256, MS / 256, 8, c2, 1, g2.K}; pg8::gemm_phase<pg8::EpiResid, pg8::FewUnitsOrder, true, true>(lds + RING_OFF, g2, O_, E2); }
                        asm volatile("s_waitcnt vmcnt(0)" ::: "memory"); __syncthreads();
                        if (threadIdx.x == 0) { __builtin_amdgcn_fence(__ATOMIC_RELEASE, "agent"); asm volatile("s_waitcnt vmcnt(0)" ::: "memory"); (void)xb_add(dflag, 1u); } }
                      if (fi + 1 < 8) { int tid2 = threadIdx.x; asm volatile("" : "+v"(tid2)); const int w2 = __builtin_amdgcn_readfirstlane(tid2 >> 6); cvt_stage(a, fi + 1, ((int)blockIdx.x - GG) * NWAVES + w2, (G - GG) * NWAVES, tid2 & 63, (LAS unsigned*)(lds + RING_OFF + w2 * 9216)); } } }
                SEAM(); } }
            if constexpr ((PH_MASK >> 2) & 1) { const pg8::Gemm g{Hb, (const bf16*)(ws + WS_FOUT + (size_t)fi * SZ_FOUT), defer_this ? MP : M, D, DFF, DFF, 0, 0}; const pg8::EpiResid E{Xb, RS + (size_t)(xv + 1) * M, 0.5f};
              GEMM_TAIL_PHASE(pg8::EpiResid, 0, g, E, (((g).M / 256) * (D / 256)) / G, (const pg8::rs_t*)nullptr, RS + (size_t)(xv + 1) * M, 0.5f); }
        }
        if (l < 4) {
            const int xv = 3 * l + 1;
            if ((l & 1) == 0) { const int e = l >> 1;
                if (ON()) { const pg8::Gemm g{Xb, (const bf16*)(ws + WS_EIN + (size_t)e * SZ_EIN), M, DINE, D, D, 0, 0}; const pg8::EpiZ E{Z, 2048, RS + (size_t)xv * M, INV_D, (bf16*)(ws + WS_UGB), M}; if constexpr ((PH_MASK >> 3) & 1) { GEMM_PHASE(pg8::EpiZ, g, E); } }
                SEAM();
                if (ON()) if constexpr ((PH_MASK >> 4) & 1) { even_prep(a, e); }
                SEAM();
                if (ON()) { { const pg8::Gemm g{Cv, (const bf16*)(ws + WS_GATE + (size_t)e * SZ_GATE), M, 2048, 256, 1024, 1, 256};
                              const pg8::EpiGate E{Cv, a.in[20] + e * 1024, a.in[22] + e * 1024, (const float*)(ws + WS_LS) + e * 1024, GAB, M}; if constexpr ((PH_MASK >> 5) & 1) { GEMM_PHASE(pg8::EpiGate, g, E); } }
                            { const pg8::Gemm g{Dp, (const bf16*)(ws + WS_POOL + (size_t)e * SZ_POOL), M, 1024, 256, 1024, 0, 256};
                              const pg8::EpiPool E{Y2, D, a.in[16] + e * 1024}; if constexpr ((PH_MASK >> 6) & 1) { pg8::StaticOrder S_; S_.init(g, G, G - 1 - (int)blockIdx.x); pg8::gemm_phase<pg8::EpiPool, pg8::StaticOrder, true, true>(lds + RING_OFF, g, S_, E); } } }
                SEAM();
                if (ON()) if constexpr ((PH_MASK >> 7) & 1) { even_scan(a, e, lds); }
                SEAM();
                if (ON()) if constexpr ((PH_MASK >> 8) & 1) { const pg8::Gemm g{Y2, (const bf16*)(ws + WS_EOUT + (size_t)e * SZ_EOUT), (G == 256) ? MP : M, D, D, D, 0, 0}; const pg8::EpiResid E{Xb, RS + (size_t)(xv + 1) * M, 1.0f}; GEMM_PHASE(pg8::EpiResid, g, E); }
                SEAM();
            } else { const int o = l >> 1;
                if (ON()) if constexpr ((PH_MASK >> 9) & 1) { s5_phase(a, o, RS + (size_t)xv * M, lds); }
                SEAM();
                if (ON()) if constexpr ((PH_MASK >> 10) & 1) { const pg8::Gemm g{Y2, (const bf16*)(ws + WS_GLU + (size_t)o * SZ_GLU), (G == 256) ? MP : M, 4096, D, D, 0, 0}; const pg8::EpiGlu E{Xb, RS + (size_t)(xv + 1) * M}; GEMM_PHASE(pg8::EpiGlu, g, E); }
                SEAM();
            }
        }
    }
    if (ON()) if constexpr ((PH_MASK >> 11) & 1) { final_norm(a, RS + (size_t)12 * M); }
#undef ON
#undef SEAM
#undef GEMM_PHASE
#undef GEMM_TAIL_PHASE
}
constexpr int N_PHASES = 1000;

extern "C" void kernel_launch(void* const* d_in, const int* in_sizes, int n_in, void* d_out, int out_size, void* d_ws, size_t ws_size, hipStream_t stream) {
    static int grid = 0;
    if (grid == 0) {
        if (n_in != 35 || (size_t)out_size != O_END || ws_size < WS_END) { fprintf(stderr, "kernel_launch: built for 35 inputs, %zu outputs, >= %zu bytes of workspace; got n_in %d, out %d, ws %zu; nothing launched\n", (size_t)O_END, (size_t)WS_END, n_in, out_size, ws_size); grid = -1; return; }
        int dev = 0, cus = 0, per_cu = 0;
        if (hipGetDevice(&dev) != hipSuccess || hipDeviceGetAttribute(&cus, hipDeviceAttributeMultiprocessorCount, dev) != hipSuccess) { fprintf(stderr, "kernel_launch: device query failed\n"); grid = -1; return; }
        if (hipFuncSetAttribute((const void*)mk_fwd, hipFuncAttributeMaxDynamicSharedMemorySize, LDS_BYTES) != hipSuccess) { fprintf(stderr, "kernel_launch: hipFuncSetAttribute failed\n"); grid = -1; return; }
        if (hipOccupancyMaxActiveBlocksPerMultiprocessor(&per_cu, (const void*)mk_fwd, NTHR, LDS_BYTES) != hipSuccess || per_cu < 1) { fprintf(stderr, "kernel_launch: occupancy query says %d workgroups per CU\n", per_cu); }
        (void)hipGetLastError();
        grid = cus;
    }
    if (grid < 0) return;
    if (hipMemsetAsync((char*)d_ws + WS_CTL, 0, CTL_ZERO_BYTES, stream) != hipSuccess) { fprintf(stderr, "kernel_launch: memset failed\n"); return; }
    Args a; memset(&a, 0, sizeof(a));
    for (int i = 0; i < 35; ++i) a.in[i] = (const float*)d_in[i];
    a.out = (float*)d_out; a.ws = (unsigned char*)d_ws;
#if MK_PER_PHASE
    for (int ph = 0; ph < N_PHASES; ++ph) { a.lo = ph; a.hi = ph + 1; hipLaunchKernelGGL(mk_fwd, dim3(grid), dim3(NTHR), LDS_BYTES, stream, a); }
#else
    a.lo = 0; a.hi = N_PHASES; hipLaunchKernelGGL(mk_fwd, dim3(grid), dim3(NTHR), LDS_BYTES, stream, a);
#endif
    const hipError_t le = hipPeekAtLastError();
    if (le != hipSuccess) fprintf(stderr, "kernel_launch: launch failed: %s\n", hipGetErrorName(le));
}
```

```cpp
#include <hip/hip_runtime.h>
#include <cstdio>
#include <cstdint>
#include <cstring>
namespace pg8 {
#define PG8_LAS __attribute__((address_space(3)))
typedef unsigned short bf16_t;
typedef short bf16x8 __attribute__((ext_vector_type(8)));
typedef float f32x4 __attribute__((ext_vector_type(4)));
typedef unsigned u32x4 __attribute__((ext_vector_type(4)));
constexpr int BM = 256, BK = 64, HALF = 128, HTB = HALF * BK * 2  , STAGE_BYTES = 8 * HTB, NXCD = 8, WGM = 8;

__host__ __device__ __forceinline__ int lds_byte(int r, int c) { const int st = (r >> 4) * 2 + (c >> 5), rr = r & 15, cc = c & 31, ob = rr * 64 + cc * 2; return st * 1024 + (ob ^ (((ob >> 9) & 1) << 5)); }
__host__ __device__ __forceinline__ void stage_rc(int b, int& R, int& C) { const int st = b / 1024, sb = b % 1024, swz = sb ^ (((sb >> 9) & 1) << 5); R = (st >> 1) * 16 + swz / 64; C = (st & 1) * 32 + (swz % 64) / 2; }
__host__ __device__ __forceinline__ int perm32(int rho) { const int n = rho >> 4, i = rho & 15; return 8 * (i >> 2) + 4 * n + (i & 3); }

struct Unit { int pm, pn, ka, kb, nt, aux; };
struct Gemm { const bf16_t* A; const bf16_t* Bt; int M, N, K, lda, ak_shift, ak_mul; };

struct StaticOrder {
    int nM, nN, nwg, G, c, imax, K, ak_shift, ak_mul;
    __host__ __device__ void init(const Gemm& g, int G_, int c_, int imax_ = 1 << 30) { nM = g.M / BM; nN = g.N / BM; nwg = nM * nN; G = G_; c = c_; imax = imax_; K = g.K; ak_shift = g.ak_shift; ak_mul = g.ak_mul; }
    __host__ __device__ void tile_of(int L, Unit& u) const {
        int wgid = L; { const int q = nwg / NXCD, r = nwg % NXCD, xcd = wgid % NXCD, off = wgid / NXCD; wgid = (xcd < r ? xcd * (q + 1) : r * (q + 1) + (xcd - r) * q) + off; }
        const int nig = WGM * nN, gid = wgid / nig, fm = gid * WGM, gsz = (nM - fm) < WGM ? (nM - fm) : WGM;
        u.pm = fm + ((wgid % nig) % gsz); u.pn = (wgid % nig) / gsz; }
    __host__ __device__ bool next(int i, Unit& u) const {
        const long L = (long)i * G + c; if (L >= nwg || i >= imax) return false;
        tile_of((int)L, u); u.ka = (u.pn >> ak_shift) * ak_mul; u.kb = 0; u.nt = K / BK; u.aux = 0; return true;
    }
    __device__ __forceinline__ void a_ready(const Unit&) const {}
    __device__ __forceinline__ void done(const Unit&) const {}
};
struct SplitTailOrder {
    StaticOrder so; int L0, ntail, nsplit, npairs;
    __host__ __device__ void init(const Gemm& g, int G_, int c_, int L0_, int ntail_, int nsplit_) { so.init(g, G_, c_); L0 = L0_; ntail = ntail_; nsplit = nsplit_; npairs = g.K / (2 * BK); }
    __host__ __device__ bool next(int i, Unit& u) const {
        if (i != 0 || so.c >= ntail * nsplit) return false;
        const int ti = so.c % ntail, s = so.c / ntail, p0 = (s * npairs) / nsplit, p1 = ((s + 1) * npairs) / nsplit;
        so.tile_of(L0 + ti, u); u.ka = p0 * 2 * BK; u.kb = u.ka; u.nt = 2 * (p1 - p0); u.aux = s * ntail + ti; return true;
    }
    __device__ __forceinline__ void a_ready(const Unit&) const {}
    __device__ __forceinline__ void done(const Unit&) const {}
};

struct SeqOrder {
    StaticOrder so, ss; int G, c, i0, i1, npu, nsu, npm, nsm, K; unsigned* flag; unsigned target;
    __host__ __device__ void init(const Gemm& g, int npanels_first, int G_, int c_, int i0_, int i1_) { Gemm gp = g; gp.M = npanels_first * BM; so.init(gp, G_, c_); gp.M = g.M - npanels_first * BM; ss.init(gp, G_, c_); G = G_; c = c_; i0 = i0_; i1 = i1_;
        npm = npanels_first; nsm = g.M / BM - npanels_first; npu = npm * (g.N / BM); nsu = nsm * (g.N / BM); K = g.K; flag = nullptr; target = 0u; }
    __host__ __device__ bool next(int i, Unit& u) const {
        const int ii = i0 + i; if (ii >= i1) return false; const int s = ii * G + c;
        if (s < npu) so.tile_of(s, u); else { const int j = s - npu; if (j >= nsu) return false; ss.tile_of(j, u); u.pm += npm; }
        u.ka = 0; u.kb = 0; u.nt = K / BK; u.aux = 0; return true; }
    __device__ __forceinline__ void a_ready(const Unit& u) const { if (flag != nullptr && u.pm >= npm) { unsigned sp_ = 0u;
            while (__hip_atomic_load(flag, __ATOMIC_RELAXED, __HIP_MEMORY_SCOPE_AGENT) < target) { __builtin_amdgcn_s_sleep(2); if (++sp_ > (1u << 22)) break; }
            __builtin_amdgcn_fence(__ATOMIC_ACQUIRE, "agent"); asm volatile("s_waitcnt vmcnt(0)" ::: "memory"); } }
    __device__ __forceinline__ void done(const Unit&) const {}
};
struct FewUnitsOrder { int pm0, npm, nN, first, cnt, K;
    __host__ __device__ bool next(int i, Unit& u) const { if (i >= cnt) return false; const int t = first + i; u.pm = pm0 + t % npm; u.pn = t / npm; u.ka = 0; u.kb = 0; u.nt = K / BK; u.aux = 0; return true; }
    __device__ __forceinline__ void a_ready(const Unit&) const {}
    __device__ __forceinline__ void done(const Unit&) const {}
};

__device__ __forceinline__ unsigned cvt_pk_bf16(float lo, float hi) { unsigned r; asm volatile("v_cvt_pk_bf16_f32 %0, %1, %2" : "=v"(r) : "v"(lo), "v"(hi)); return r; }
typedef float f32x2 __attribute__((ext_vector_type(2)));
typedef unsigned u32x2 __attribute__((ext_vector_type(2)));
constexpr float RMS_EPS = 1e-6f;
typedef unsigned long long rs_t;
__device__ __forceinline__ void rs_add(rs_t* p, float ss) { atomicAdd(p, (rs_t)(ss * 1048576.0f + 0.5f)); }
__device__ __forceinline__ float rs_get(rs_t v) { return (float)v * (1.0f / 1048576.0f); }
__device__ __forceinline__ float bf_lo(unsigned u) { return __builtin_bit_cast(float, u << 16); }
__device__ __forceinline__ float bf_hi(unsigned u) { return __builtin_bit_cast(float, u & 0xffff0000u); }
__device__ __forceinline__ float sigmoidf_fast(float x) { return __builtin_amdgcn_rcpf(1.0f + __expf(-x)); }
__device__ __forceinline__ float rstd_of(float sumsq, float inv_n) { return __builtin_amdgcn_rsqf(sumsq * inv_n + RMS_EPS); }

struct EpiSwiglu {
    static constexpr bool PERM = true, AFTER_DRAIN = false;
    bf16_t* H; int ldh; const rs_t* rs; float inv_n;
    __device__ __forceinline__ void operator()(const f32x4 (&acc)[2][2][4][2], const Unit& u, int wr, int wc, int fr, int fq) const {
        const int row0 = u.pm * BM + wr * 64 + fr, col0 = u.pn * HALF + wc * 32 + 8 * fq;
#pragma unroll
        for (int ai = 0; ai < 2; ++ai)
#pragma unroll
            for (int m = 0; m < 4; ++m) { const int row = row0 + ai * HALF + m * 16;
                const float ms = rs_get(rs[row]) * inv_n + RMS_EPS, c2 = -1.4426950408889634f * __builtin_amdgcn_rsqf(ms);
                float h[8];
#pragma unroll
                for (int n = 0; n < 2; ++n)
#pragma unroll
                    for (int e = 0; e < 4; ++e) { const float g = acc[ai][0][m][n][e], uu = acc[ai][1][m][n][e]; const float ex = __builtin_amdgcn_exp2f(g * c2); h[4 * n + e] = (g * uu) * __builtin_amdgcn_rcpf(__builtin_fmaf(ex, ms, ms)); }
                u32x4 w; w.x = cvt_pk_bf16(h[0], h[1]); w.y = cvt_pk_bf16(h[2], h[3]); w.z = cvt_pk_bf16(h[4], h[5]); w.w = cvt_pk_bf16(h[6], h[7]);
                *(u32x4*)(H + (size_t)row * ldh + col0) = w; }
    }
};
struct EpiResid {
    static constexpr bool PERM = true, AFTER_DRAIN = false;
    bf16_t* Xb; rs_t* rsn; float alpha;
    __device__ __forceinline__ void operator()(const f32x4 (&acc)[2][2][4][2], const Unit& u, int wr, int wc, int fr, int fq) const {
        const int row0 = u.pm * BM + wr * 64 + fr, col0 = u.pn * BM + wc * 32 + 8 * fq;
#pragma unroll
        for (int ai = 0; ai < 2; ++ai)
#pragma unroll
            for (int m = 0; m < 4; ++m) { const int row = row0 + ai * HALF + m * 16; float ss = 0.f;
#pragma unroll
                for (int bj = 0; bj < 2; ++bj) { const size_t off = (size_t)row * 2048 + col0 + bj * HALF; const u32x4 xo = *(const u32x4*)(Xb + off);
                    const f32x4 a0 = acc[ai][bj][m][0], a1 = acc[ai][bj][m][1];
                    u32x4 w; w.x = cvt_pk_bf16(bf_lo(xo.x) + a0[0] * alpha, bf_hi(xo.x) + a0[1] * alpha); w.y = cvt_pk_bf16(bf_lo(xo.y) + a0[2] * alpha, bf_hi(xo.y) + a0[3] * alpha);
                    w.z = cvt_pk_bf16(bf_lo(xo.z) + a1[0] * alpha, bf_hi(xo.z) + a1[1] * alpha); w.w = cvt_pk_bf16(bf_lo(xo.w) + a1[2] * alpha, bf_hi(xo.w) + a1[3] * alpha);
                    *(u32x4*)(Xb + off) = w;
                    const float v0 = bf_lo(w.x), v1 = bf_hi(w.x), v2 = bf_lo(w.y), v3 = bf_hi(w.y), v4 = bf_lo(w.z), v5 = bf_hi(w.z), v6 = bf_lo(w.w), v7 = bf_hi(w.w);
                    ss += ((v0 * v0 + v1 * v1) + (v2 * v2 + v3 * v3)) + ((v4 * v4 + v5 * v5) + (v6 * v6 + v7 * v7)); }
                ss += __shfl_xor(ss, 16); ss += __shfl_xor(ss, 32);
                if (fq == 0) rs_add(rsn + row, ss); }
    }
};
struct EpiGlu {
    static constexpr bool PERM = true, AFTER_DRAIN = false;
    bf16_t* Xb; rs_t* rsn;
    __device__ __forceinline__ void operator()(const f32x4 (&acc)[2][2][4][2], const Unit& u, int wr, int wc, int fr, int fq) const {
        const int row0 = u.pm * BM + wr * 64 + fr, col0 = u.pn * HALF + wc * 32 + 8 * fq;
#pragma unroll
        for (int ai = 0; ai < 2; ++ai)
#pragma unroll
            for (int m = 0; m < 4; ++m) { const int row = row0 + ai * HALF + m * 16; const size_t off = (size_t)row * 2048 + col0; const u32x4 xo = *(const u32x4*)(Xb + off);
                float v[8] = {bf_lo(xo.x), bf_hi(xo.x), bf_lo(xo.y), bf_hi(xo.y), bf_lo(xo.z), bf_hi(xo.z), bf_lo(xo.w), bf_hi(xo.w)};
#pragma unroll
                for (int n = 0; n < 2; ++n)
#pragma unroll
                    for (int e = 0; e < 4; ++e) v[4 * n + e] += acc[ai][0][m][n][e] * sigmoidf_fast(acc[ai][1][m][n][e]);
                u32x4 w; w.x = cvt_pk_bf16(v[0], v[1]); w.y = cvt_pk_bf16(v[2], v[3]); w.z = cvt_pk_bf16(v[4], v[5]); w.w = cvt_pk_bf16(v[6], v[7]); *(u32x4*)(Xb + off) = w;
                const float v0 = bf_lo(w.x), v1 = bf_hi(w.x), v2 = bf_lo(w.y), v3 = bf_hi(w.y), v4 = bf_lo(w.z), v5 = bf_hi(w.z), v6 = bf_lo(w.w), v7 = bf_hi(w.w);
                float ss = ((v0 * v0 + v1 * v1) + (v2 * v2 + v3 * v3)) + ((v4 * v4 + v5 * v5) + (v6 * v6 + v7 * v7));
                ss += __shfl_xor(ss, 16); ss += __shfl_xor(ss, 32);
                if (fq == 0) rs_add(rsn + row, ss); }
    }
};
struct EpiPartial {
    static constexpr bool PERM = true, AFTER_DRAIN = false;
    bf16_t* P;
    __device__ __forceinline__ void operator()(const f32x4 (&acc)[2][2][4][2], const Unit& u, int wr, int wc, int fr, int fq) const {
        bf16_t* base = P + (size_t)u.aux * (BM * BM) + (size_t)(wr * 64 + fr) * BM + wc * 32 + 8 * fq;
#pragma unroll
        for (int ai = 0; ai < 2; ++ai)
#pragma unroll
            for (int m = 0; m < 4; ++m) { bf16_t* rowp = base + (size_t)(ai * HALF + m * 16) * BM;
#pragma unroll
                for (int bj = 0; bj < 2; ++bj) { const f32x4 v0 = acc[ai][bj][m][0], v1 = acc[ai][bj][m][1];
                    u32x4 w; w.x = cvt_pk_bf16(v0[0], v0[1]); w.y = cvt_pk_bf16(v0[2], v0[3]); w.z = cvt_pk_bf16(v1[0], v1[1]); w.w = cvt_pk_bf16(v1[2], v1[3]); *(u32x4*)(rowp + bj * HALF) = w; } }
    }
};
struct EpiZ {
    static constexpr bool PERM = true, AFTER_DRAIN = false;
    bf16_t* Z; int ldz; const rs_t* rs; float inv_n; bf16_t* UGb; int Mrows;
    __device__ __forceinline__ void operator()(const f32x4 (&acc)[2][2][4][2], const Unit& u, int wr, int wc, int fr, int fq) const {
        const int row0 = u.pm * BM + wr * 64 + fr, col0 = u.pn * BM + wc * 32 + 8 * fq; const bool gate = u.pn >= 8;
#pragma unroll
        for (int ai = 0; ai < 2; ++ai)
#pragma unroll
            for (int m = 0; m < 4; ++m) { const int row = row0 + ai * HALF + m * 16; const float rstd = rstd_of(rs_get(rs[row]), inv_n); bf16_t* rowp = Z + (size_t)row * ldz + col0;
#pragma unroll
                for (int bj = 0; bj < 2; ++bj) { const f32x4 v0 = acc[ai][bj][m][0] * rstd, v1 = acc[ai][bj][m][1] * rstd;
                    u32x4 w; w.x = cvt_pk_bf16(v0[0], v0[1]); w.y = cvt_pk_bf16(v0[2], v0[3]); w.z = cvt_pk_bf16(v1[0], v1[1]); w.w = cvt_pk_bf16(v1[2], v1[3]);
                    if (gate) { const int cb = (u.pn - 8) * 16 + bj * 8 + wc * 2 + (fq >> 1); *(u32x4*)(UGb + ((size_t)cb * Mrows + row) * 16 + 8 * (fq & 1)) = w; }
                    else *(u32x4*)(rowp + bj * HALF) = w; } }
    }
};
struct EpiGate {
    static constexpr bool PERM = true, AFTER_DRAIN = false;
    const bf16_t* cvb; const float* ba; const float* bx; const float* ls; unsigned* GAB; int Mrows;
    __device__ __forceinline__ void operator()(const f32x4 (&acc)[2][2][4][2], const Unit& u, int wr, int wc, int fr, int fq) const {
        const int row0 = u.pm * BM + wr * 64 + fr, ch0 = u.pn * HALF + wc * 32 + 8 * fq;
        unsigned* gbase = GAB + ((size_t)(u.pn * 8 + wc * 2 + (fq >> 1)) * Mrows) * 16 + 8 * (fq & 1);
#pragma unroll
        for (int n = 0; n < 2; ++n) { const f32x4 bav = *(const f32x4*)(ba + ch0 + n * 4) * -1.4426950408889634f, bxv = *(const f32x4*)(bx + ch0 + n * 4) * -1.4426950408889634f, lsv = *(const f32x4*)(ls + ch0 + n * 4) * 8.0f;
#pragma unroll
            for (int ai = 0; ai < 2; ++ai)
#pragma unroll
                for (int m = 0; m < 4; ++m) { const int row = row0 + ai * HALF + m * 16; const bool first = (row < 8192) && ((row & 2047) == 0);
                    const u32x2 cw = *(const u32x2*)(cvb + (size_t)row * 1024 + ch0 + n * 4); const float cv[4] = {bf_lo(cw.x), bf_hi(cw.x), bf_lo(cw.y), bf_hi(cw.y)}; u32x4 w;
#pragma unroll
                    for (int e = 0; e < 4; ++e) {
                        const float r = __builtin_amdgcn_rcpf(1.0f + __builtin_amdgcn_exp2f(__builtin_fmaf(acc[ai][0][m][n][e], -1.4426950408889634f, bav[e])));
                        const float ig = __builtin_amdgcn_rcpf(1.0f + __builtin_amdgcn_exp2f(__builtin_fmaf(acc[ai][1][m][n][e], -1.4426950408889634f, bxv[e])));
                        float la = r * lsv[e]; const float x2 = la + la, a2 = __builtin_amdgcn_exp2f(x2 * 1.4426950408889634f);
                        const float om = (x2 > -0.1f) ? -x2 * (1.0f + x2 * (0.5f + x2 * (0.16666667f + x2 * 0.041666668f))) : 1.0f - a2;
                        float mult = __builtin_amdgcn_sqrtf(om);
                        if (first) { la = -30.0f; mult = 1.f; }
                        w[e] = cvt_pk_bf16(la, mult * ig * cv[e]); }
                    *(u32x4*)(gbase + (size_t)row * 16 + n * 4) = w;
                    asm volatile("" ::: "memory"); } }
    }
};
struct EpiPool {
    static constexpr bool PERM = true, AFTER_DRAIN = false;
    bf16_t* Y; int ldy; const float* scale;
    __device__ __forceinline__ void operator()(const f32x4 (&acc)[2][2][4][2], const Unit& u, int wr, int wc, int fr, int fq) const {
        const int row0 = u.pm * BM + wr * 64 + fr, col0 = u.pn * BM + wc * 32 + 8 * fq;
#pragma unroll
        for (int bj = 0; bj < 2; ++bj) { const f32x4 s0 = *(const f32x4*)(scale + col0 + bj * HALF), s1 = *(const f32x4*)(scale + col0 + bj * HALF + 4);
#pragma unroll
            for (int ai = 0; ai < 2; ++ai)
#pragma unroll
                for (int m = 0; m < 4; ++m) { bf16_t* rowp = Y + (size_t)(row0 + ai * HALF + m * 16) * ldy + col0 + bj * HALF;
                    const f32x4 v0 = acc[ai][bj][m][0] * s0, v1 = acc[ai][bj][m][1] * s1;
                    u32x4 w; w.x = cvt_pk_bf16(v0[0], v0[1]); w.y = cvt_pk_bf16(v0[2], v0[3]); w.z = cvt_pk_bf16(v1[0], v1[1]); w.w = cvt_pk_bf16(v1[2], v1[3]);
                    *(u32x4*)rowp = w; } }
    }
};

template <class Epi, class Sched, bool ALIGN_EPI = false, bool SP2 = false>
__device__ __forceinline__ void gemm_phase(PG8_LAS unsigned char* lds, const Gemm g, const Sched& S, const Epi& E) {
    int tid_ = threadIdx.x; asm volatile("" : "+v"(tid_));
    const int tid = tid_, wid = __builtin_amdgcn_readfirstlane(tid >> 6), lane = tid & 63, wr = wid >> 2, wc = wid & 3, fr = lane & 15, fq = lane >> 4;
    const int K = g.K;
    unsigned voffA[2], voffB[2];
#pragma unroll
    for (int i = 0; i < 2; ++i) { int R, C; stage_rc(tid * 16 + i * 8192, R, C); const int Rb = Epi::PERM ? ((R & ~31) + perm32(R & 31)) : R;
        voffA[i] = (unsigned)(R * g.lda + C) * 2u; voffB[i] = (unsigned)(Rb * K + C) * 2u; }
    const size_t kstep = (size_t)(BK * 2);
    const size_t hA = (size_t)HALF * g.lda * 2, hB = (size_t)HALF * K * 2;
    const size_t tA = 2 * hA, tB = 2 * hB;
    const unsigned ldsw = (unsigned)wid * 1024u;
    const int aoff = lds_byte(wr * 64 + fr, fq * 8), boff = lds_byte(wc * 32 + fr, fq * 8);
#define PG8_SA(b, h) (((b) * 2 + (h)) * HTB)
#define PG8_SB(b, h) ((4 + (b) * 2 + (h)) * HTB)
#define PG8_STAGE(bufoff, gbase, voff) do { _Pragma("unroll") for (int _i = 0; _i < 2; ++_i) \
        __builtin_amdgcn_global_load_lds((const unsigned*)((const char*)(gbase) + (voff)[_i]), (PG8_LAS unsigned*)(lds + (bufoff) + ldsw + _i * 8192), 16, 0, 0); } while (0)
#define PG8_LDA(dst, b, h) do { _Pragma("unroll") for (int m = 0; m < 4; ++m) _Pragma("unroll") for (int k = 0; k < 2; ++k) dst[m][k] = *(const PG8_LAS bf16x8*)(lds + PG8_SA(b, h) + aoff + m * 2048 + k * 1024); } while (0)
#define PG8_LDB(dst, b, h) do { _Pragma("unroll") for (int n = 0; n < 2; ++n) _Pragma("unroll") for (int k = 0; k < 2; ++k) dst[n][k] = *(const PG8_LAS bf16x8*)(lds + PG8_SB(b, h) + boff + n * 2048 + k * 1024); } while (0)
#define PG8_MMA(ai, bj, At, Bt) do { __builtin_amdgcn_s_setprio(1); _Pragma("unroll") for (int m = 0; m < 4; ++m) _Pragma("unroll") for (int n = 0; n < 2; ++n) _Pragma("unroll") for (int k = 0; k < 2; ++k) \
        acc[ai][bj][m][n] = __builtin_amdgcn_mfma_f32_16x16x32_bf16(Bt[n][k], At[m][k], acc[ai][bj][m][n], 0, 0, 0); __builtin_amdgcn_s_setprio(0); } while (0)
#define PG8_WAIT_V(n) asm volatile("s_waitcnt vmcnt(" #n ")" ::: "memory")
#define PG8_WAIT_L(n) asm volatile("s_waitcnt lgkmcnt(" #n ")" ::: "memory")
#define PG8_BAR __builtin_amdgcn_s_barrier()
#define PG8_SCHED __builtin_amdgcn_sched_barrier(0)
    Unit cur, nxt; int ui = 0;
    if (!S.next(0, cur)) return;
    f32x4 acc[2][2][4][2];
#pragma unroll
    for (int a = 0; a < 2; ++a)
#pragma unroll
        for (int b = 0; b < 2; ++b)
#pragma unroll
            for (int m = 0; m < 4; ++m)
#pragma unroll
                for (int n = 0; n < 2; ++n) acc[a][b][m][n] = (f32x4){0.f, 0.f, 0.f, 0.f};
    bf16x8 At[4][2], B0[2][2], B1[2][2];
    const char* cA = (const char*)g.A + (size_t)cur.pm * tA + (size_t)cur.ka * 2; const char* cB = (const char*)g.Bt + (size_t)cur.pn * tB + (size_t)cur.kb * 2; int nt = cur.nt;
    S.a_ready(cur);
    if constexpr (SP2) {
        PG8_STAGE(PG8_SB(0, 0), cB, voffB); PG8_STAGE(PG8_SB(0, 1), cB + hB, voffB); PG8_STAGE(PG8_SA(0, 0), cA, voffA); PG8_STAGE(PG8_SA(0, 1), cA + hA, voffA);
        if (wr == 1) PG8_BAR;
        PG8_WAIT_V(2); PG8_BAR;
        PG8_STAGE(PG8_SB(1, 0), cB + kstep, voffB); PG8_STAGE(PG8_SA(1, 0), cA + kstep, voffA); PG8_STAGE(PG8_SB(1, 1), cB + hB + kstep, voffB);
        PG8_WAIT_V(6); PG8_BAR;
    } else {
        PG8_STAGE(PG8_SB(0, 0), cB, voffB); PG8_STAGE(PG8_SA(0, 0), cA, voffA); PG8_STAGE(PG8_SB(0, 1), cB + hB, voffB); PG8_STAGE(PG8_SA(0, 1), cA + hA, voffA);
        if (wr == 1) PG8_BAR;
        PG8_WAIT_V(4); PG8_BAR;
        PG8_STAGE(PG8_SB(1, 0), cB + kstep, voffB); PG8_STAGE(PG8_SA(1, 0), cA + kstep, voffA); PG8_STAGE(PG8_SB(1, 1), cB + hB + kstep, voffB);
        PG8_WAIT_V(6); PG8_BAR;
    }
    for (;;) {
        const bool has_next = S.next(ui + 1, nxt);
        const char* nA = has_next ? (const char*)g.A + (size_t)nxt.pm * tA + (size_t)nxt.ka * 2 : cA; const char* nB = has_next ? (const char*)g.Bt + (size_t)nxt.pn * tB + (size_t)nxt.kb * 2 : cB;
#pragma nounroll
        for (int t = 0; t < nt; t += 2) {
            const bool last = (t == nt - 2);
            const char* a1 = cA + (size_t)(t + 1) * kstep;
            const char* a2 = last ? nA : cA + (size_t)(t + 2) * kstep; const char* b2 = last ? nB : cB + (size_t)(t + 2) * kstep;
            const char* a3 = a2 + kstep; const char* b3 = b2 + kstep;
            if (last && has_next) S.a_ready(nxt);
            if constexpr (SP2) {
            PG8_LDB(B0, 0, 0); PG8_LDB(B1, 0, 1); PG8_SCHED; PG8_LDA(At, 0, 0); PG8_STAGE(PG8_SA(1, 1), a1 + hA, voffA);
            PG8_WAIT_V(8); PG8_WAIT_L(0); PG8_BAR; PG8_MMA(0, 0, At, B0); PG8_MMA(0, 1, At, B1); PG8_BAR; PG8_SCHED;
            PG8_LDA(At, 0, 1); PG8_STAGE(PG8_SB(0, 0), b2, voffB); PG8_STAGE(PG8_SB(0, 1), b2 + hB, voffB); PG8_STAGE(PG8_SA(0, 0), a2, voffA);
            PG8_WAIT_V(8); PG8_WAIT_L(0); PG8_BAR; PG8_MMA(1, 0, At, B0); PG8_MMA(1, 1, At, B1); PG8_BAR; PG8_SCHED;
            PG8_LDB(B0, 1, 0); PG8_LDB(B1, 1, 1); PG8_SCHED; PG8_LDA(At, 1, 0); PG8_STAGE(PG8_SA(0, 1), a2 + hA, voffA);
            PG8_WAIT_V(8); PG8_WAIT_L(0); PG8_BAR; PG8_MMA(0, 0, At, B0); PG8_MMA(0, 1, At, B1); PG8_BAR; PG8_SCHED;
            PG8_LDA(At, 1, 1); PG8_STAGE(PG8_SB(1, 0), b3, voffB); PG8_STAGE(PG8_SB(1, 1), b3 + hB, voffB); PG8_STAGE(PG8_SA(1, 0), a3, voffA);
            PG8_WAIT_V(8); PG8_WAIT_L(0); PG8_BAR; PG8_MMA(1, 0, At, B0); PG8_MMA(1, 1, At, B1); PG8_BAR; PG8_SCHED;
            } else {
            PG8_LDB(B0, 0, 0); PG8_SCHED; PG8_LDA(At, 0, 0); PG8_STAGE(PG8_SA(1, 1), a1 + hA, voffA);
            PG8_WAIT_L(8); PG8_BAR; PG8_WAIT_L(0); PG8_MMA(0, 0, At, B0); PG8_BAR; PG8_SCHED;
            PG8_LDB(B1, 0, 1); PG8_STAGE(PG8_SB(0, 0), b2, voffB);
            PG8_BAR; PG8_WAIT_L(0); PG8_MMA(0, 1, At, B1); PG8_BAR;
            PG8_LDA(At, 0, 1); PG8_STAGE(PG8_SA(0, 0), a2, voffA);
            PG8_BAR; PG8_WAIT_L(0); PG8_MMA(1, 0, At, B0); PG8_BAR; PG8_SCHED;
            PG8_STAGE(PG8_SB(0, 1), b2 + hB, voffB);
            PG8_WAIT_V(6); PG8_BAR; PG8_MMA(1, 1, At, B1); PG8_BAR;
            PG8_LDB(B0, 1, 0); PG8_SCHED; PG8_LDA(At, 1, 0); PG8_STAGE(PG8_SA(0, 1), a2 + hA, voffA);
            PG8_WAIT_L(8); PG8_BAR; PG8_WAIT_L(0); PG8_MMA(0, 0, At, B0); PG8_BAR; PG8_SCHED;
            PG8_LDB(B1, 1, 1); PG8_STAGE(PG8_SB(1, 0), b3, voffB);
            PG8_BAR; PG8_WAIT_L(0); PG8_MMA(0, 1, At, B1); PG8_BAR;
            PG8_LDA(At, 1, 1); PG8_STAGE(PG8_SA(1, 0), a3, voffA);
            PG8_BAR; PG8_WAIT_L(0); PG8_MMA(1, 0, At, B0); PG8_BAR; PG8_SCHED;
            PG8_STAGE(PG8_SB(1, 1), b3 + hB, voffB);
            PG8_WAIT_V(6); PG8_BAR; PG8_MMA(1, 1, At, B1); PG8_BAR;
            }
        }
        if constexpr (ALIGN_EPI) { if (wr == 0) PG8_BAR; }
        if constexpr (!Epi::AFTER_DRAIN) { E(acc, cur, wr, wc, fr, fq); S.done(cur); }
        if (!has_next) break;
#pragma unroll
        for (int a = 0; a < 2; ++a)
#pragma unroll
            for (int b = 0; b < 2; ++b)
#pragma unroll
                for (int m = 0; m < 4; ++m)
#pragma unroll
                    for (int n = 0; n < 2; ++n) acc[a][b][m][n] = (f32x4){0.f, 0.f, 0.f, 0.f};
        cur = nxt; cA = nA; cB = nB; nt = cur.nt; ++ui;
        if constexpr (ALIGN_EPI) { if (wr == 1) PG8_BAR; }
    }
    PG8_WAIT_V(0);
    if constexpr (!ALIGN_EPI) { if (wr == 0) PG8_BAR; }
    PG8_BAR;
    if constexpr (Epi::AFTER_DRAIN) { E.fused(acc, cur, wr, wc, fr, fq, lds, wid, lane); S.done(cur); }
#undef PG8_SA
#undef PG8_SB
#undef PG8_STAGE
#undef PG8_LDA
#undef PG8_LDB
#undef PG8_MMA
#undef PG8_WAIT_V
#undef PG8_WAIT_L
#undef PG8_BAR
#undef PG8_SCHED
}
}

constexpr int D = 2048, NBP = 4, SEQ = 2048, NBS = 128, DSQ = 8, MP = NBP * SEQ, MS = NBS * DSQ, M = MP + MS;
constexpr int DFF = 5504, NFF = 2 * DFF, DPOOL = 1024, DRNN = 1024, DINE = 3072, POOLBUF = 15, NGRP = 128, NST = 64;
constexpr int NWAVES = 8, NTHR = 512;
constexpr float INV_D = 1.0f / 2048.0f;

constexpr size_t MiB = 1u << 20;
constexpr size_t WS_CTL = 0, CTL_ZERO_BYTES = 2 * MiB;
constexpr int CW_TMO = 0, CW_BAR = 4096, CW_FLAG = 8192;
constexpr size_t WS_RS = 64 * 1024;
constexpr int NRS = 14;
static_assert(WS_RS + (size_t)NRS * M * 8 <= CTL_ZERO_BYTES, "RS inside the memset region");
constexpr size_t SZ_FIN = (size_t)NFF * D * 2, SZ_FOUT = (size_t)D * DFF * 2, SZ_EIN = (size_t)DINE * D * 2, SZ_EOUT = (size_t)D * D * 2, SZ_POOL = (size_t)1024 * 256 * 2, SZ_GATE = (size_t)2048 * 256 * 2, SZ_GLU = (size_t)4096 * D * 2;
constexpr size_t WS_FIN = 2 * MiB, WS_FOUT = WS_FIN + 8 * SZ_FIN, WS_EIN = WS_FOUT + 8 * SZ_FOUT, WS_EOUT = WS_EIN + 2 * SZ_EIN, WS_POOL = WS_EOUT + 2 * SZ_EOUT, WS_GATE = WS_POOL + 2 * SZ_POOL, WS_GLU = WS_GATE + 2 * SZ_GATE;
constexpr size_t WS_AB = WS_GLU + 2 * SZ_GLU;
constexpr size_t WS_BB = WS_AB + (size_t)2 * 128 * 64 * 2 * 4;
constexpr size_t WS_LS = WS_BB + (size_t)2 * 128 * 64 * 32 * 4;
constexpr size_t WS_W1 = (WS_LS + 2 * 1024 * 4 + 255) / 256 * 256;
constexpr size_t WS_XB = WS_W1 + (size_t)2 * 128 * 128 * 256 * 2;
constexpr size_t WS_ACT = WS_XB + (size_t)M * D * 2;
constexpr size_t WS_H = WS_ACT;
constexpr size_t WS_Z = WS_ACT;
constexpr size_t WS_DP = WS_Z + (size_t)M * DINE * 4;
constexpr size_t WS_CV = WS_DP + (size_t)M * 1024 * 2;
constexpr size_t WS_CVF = WS_CV + (size_t)M * 1024 * 2;
constexpr size_t WS_GA = WS_CVF + (size_t)M * 1024 * 4;
constexpr size_t WS_GB = WS_GA + (size_t)M * 1024 * 4;
constexpr size_t WS_Y2 = WS_GB + (size_t)M * 1024 * 4;
constexpr size_t WS_UGB = WS_Y2 + (size_t)M * D * 2;
constexpr size_t WS_PART = WS_DP;
constexpr size_t WS_END = WS_UGB + (size_t)M * 1024 * 4;
static_assert(WS_H + (size_t)M * DFF * 2 <= WS_DP, "H overlays Z only");
static_assert(WS_PART + (size_t)256 * 65536 * 2 <= WS_END, "partial slabs fit");

constexpr size_t O_YP = 0, O_YS = O_YP + (size_t)MP * D, O_POOLP = O_YS + (size_t)MS * D, O_POOLS = O_POOLP + (size_t)2 * NBP * 15 * 1024, O_CONVP = O_POOLS + (size_t)2 * NBS * 15 * 1024,
                 O_CONVS = O_CONVP + (size_t)2 * NBP * 3 * 1024, O_HP = O_CONVS + (size_t)2 * NBS * 3 * 1024, O_HS = O_HP + (size_t)2 * NBP * 1024, O_REP = O_HS + (size_t)2 * NBS * 1024,
                 O_RES = O_REP + (size_t)2 * NBP * 128 * 64, O_IMP = O_RES + (size_t)2 * NBS * 128 * 64, O_IMS = O_IMP + (size_t)2 * NBP * 128 * 64, O_END = O_IMS + (size_t)2 * NBS * 128 * 64;

constexpr int RING_OFF = 0, RING_BYTES = 131072;
constexpr int LDSCTL_OFF = RING_BYTES, MISC_OFF = LDSCTL_OFF + 320;
constexpr int LDS_BYTES = 147456;
static_assert(MISC_OFF + 128 <= LDS_BYTES, "LDS map");

#define GAS __attribute__((address_space(1)))
#define LAS __attribute__((address_space(3)))
typedef unsigned short bf16;
typedef unsigned v4u __attribute__((ext_vector_type(4)));
typedef unsigned v2u __attribute__((ext_vector_type(2)));
typedef float f32x4 __attribute__((ext_vector_type(4)));
typedef GAS unsigned gu32;
#define RLX_AGENT __ATOMIC_RELAXED, __HIP_MEMORY_SCOPE_AGENT
#define LDS_WAIT() asm volatile("s_waitcnt lgkmcnt(0)" ::: "memory")
#define VM_WAIT() asm volatile("s_waitcnt vmcnt(0)" ::: "memory")
__device__ __forceinline__ unsigned f2bf(float f) { unsigned u = __builtin_bit_cast(unsigned, f); return (u + 0x7fffu + ((u >> 16) & 1u)) >> 16; }
typedef __bf16 bf16x2v __attribute__((ext_vector_type(2)));
typedef float f32x2c __attribute__((ext_vector_type(2)));
__device__ __forceinline__ unsigned pk2(float lo, float hi) { const bf16x2v b = __builtin_convertvector((f32x2c){lo, hi}, bf16x2v); return __builtin_bit_cast(unsigned, b); }
__device__ __forceinline__ float bf_lo(unsigned u) { return __builtin_bit_cast(float, u << 16); }
__device__ __forceinline__ float bf_hi(unsigned u) { return __builtin_bit_cast(float, u & 0xffff0000u); }
__device__ __forceinline__ float wave_sum(float v) {
#pragma unroll
    for (int o = 1; o < 64; o <<= 1) v += __shfl_xor(v, o);
    return v;
}
__device__ __forceinline__ float gelu_tanh(float v) { const float z = 1.5957691216057308f * (v + 0.044715f * v * v * v); return v * __builtin_amdgcn_rcpf(1.0f + __expf(-z)); }

#define XB_TMO      128
#define XB_XCNT(j)  (256  + 64 * (j))
#define XB_XSUB(j)  (1280 + 64 * (j))
#define XB_XGEN(j)  (2304 + 64 * (j))
#define XB_TOP      3328
#define XB_TOPGEN   3392
#define XCD_BAR_WORDS 3456
#define XB_SPIN_CAP (1u << 18)

__device__ __forceinline__ unsigned xb_ld(unsigned* p)              { return __hip_atomic_load(p, __ATOMIC_RELAXED, __HIP_MEMORY_SCOPE_AGENT); }
__device__ __forceinline__ unsigned xb_add(unsigned* p, unsigned v) { return __hip_atomic_fetch_add(p, v, __ATOMIC_RELAXED, __HIP_MEMORY_SCOPE_AGENT); }
__device__ __forceinline__ unsigned xb_xcc_id() { return (unsigned)__builtin_amdgcn_s_getreg((3 << 11) | 20) & 0xFu; }
#define XB_SPIN(cond, bar) do { unsigned _sp = 0; while (cond) { __builtin_amdgcn_s_sleep(1); \
    if ((++_sp & 255u) == 0u) { if (xb_ld(&(bar)[XB_TMO])) break; if (_sp > XB_SPIN_CAP) { atomicAdd(&(bar)[XB_TMO], 1u); break; } } } } while (0)

struct XcdBarrier {
    unsigned* bar; unsigned x;
    volatile LAS unsigned* st;
};

__device__ __forceinline__ XcdBarrier xcd_barrier_post(unsigned* bar, volatile LAS unsigned* st) {
    XcdBarrier b; b.bar = bar; b.x = xb_xcc_id(); b.st = st;
    if (threadIdx.x == 0) (void)xb_add(&bar[XB_XCNT(b.x)], 1u);
    return b;
}
__device__ __forceinline__ void xcd_barrier_complete(unsigned* bar, unsigned x, unsigned& nloc, unsigned& nx) {
    const unsigned G = gridDim.x * gridDim.y * gridDim.z;
    unsigned sum, cnt, mine, sp = 0u;
    for (;;) {
        sum = 0u; cnt = 0u; mine = 0u;
#pragma unroll
        for (unsigned j = 0; j < 16; ++j) { const unsigned c = xb_ld(&bar[XB_XCNT(j)]); sum += c; cnt += (c > 0u) ? 1u : 0u; mine = (j == x) ? c : mine; }
        if (sum == G) break;
        __builtin_amdgcn_s_sleep(1);
        if ((++sp & 255u) == 0u) { if (xb_ld(&bar[XB_TMO])) break; if (sp > XB_SPIN_CAP) { atomicAdd(&bar[XB_TMO], 1u); break; } }
    }
    nloc = mine > 0u ? mine : 1u; nx = cnt > 0u ? cnt : 1u;
}

__device__ __forceinline__ void xcd_barrier(const XcdBarrier& b) {
    asm volatile("s_waitcnt vmcnt(0)" ::: "memory");
    __syncthreads();
    if (threadIdx.x == 0) {
        unsigned* bar = b.bar;
        __builtin_amdgcn_s_waitcnt(0);
        unsigned nloc = b.st[0], nx = b.st[1];
        if (nloc == 0u) { xcd_barrier_complete(bar, b.x, nloc, nx); b.st[0] = nloc; b.st[1] = nx; }
        const unsigned old = xb_add(&bar[XB_XSUB(b.x)], 1u);
        const unsigned gen = old / nloc;
        if (old + 1u == (gen + 1u) * nloc) {
            __builtin_amdgcn_fence(__ATOMIC_RELEASE, "agent");
            asm volatile("s_waitcnt vmcnt(0)" ::: "memory");
            const unsigned og = xb_add(&bar[XB_TOP], 1u);
            const unsigned tg = og / nx;
            if (og + 1u == (tg + 1u) * nx) xb_add(&bar[XB_TOPGEN], 1u);
            else XB_SPIN(xb_ld(&bar[XB_TOPGEN]) == tg, bar);
            __builtin_amdgcn_fence(__ATOMIC_ACQUIRE, "agent");
            xb_add(&bar[XB_XGEN(b.x)], 1u);
            asm volatile("s_waitcnt vmcnt(0)" ::: "memory");
        } else {
            XB_SPIN(xb_ld(&bar[XB_XGEN(b.x)]) == gen, bar);
            __builtin_amdgcn_fence(__ATOMIC_ACQUIRE, "agent");
            asm volatile("s_waitcnt vmcnt(0)" ::: "memory");
        }
    }
    __syncthreads();
}
struct Args { const float* in[35]; float* out; unsigned char* ws; int lo, hi; };

struct CvtJob { const float* W; const float* ks; bf16* dst; int ldw, K, Nd, kind, HO, ldd; };
__device__ __forceinline__ void cvt_item(const CvtJob& j, int item, int lane, LAS unsigned* T) {
    const int nblk = j.Nd >> 6, kb = item / nblk, nb = item - kb * nblk, k0 = kb * 64, n0 = nb * 64;
    int sc0 = n0; if (j.kind == 1) sc0 = ((n0 >> 7) & 1) * j.HO + (n0 >> 8) * 128 + (n0 & 127);
    const float* src = j.W + (size_t)k0 * j.ldw + sc0 + lane;
    float v[64];
#pragma unroll
    for (int kk = 0; kk < 64; ++kk) v[kk] = __builtin_nontemporal_load(src + (size_t)kk * j.ldw);
    if (j.ks) {
#pragma unroll
        for (int kk = 0; kk < 64; ++kk) v[kk] *= j.ks[k0 + kk]; }
#pragma unroll
    for (int q = 0; q < 8; ++q) { v4u o; o.x = pk2(v[8 * q], v[8 * q + 1]); o.y = pk2(v[8 * q + 2], v[8 * q + 3]); o.z = pk2(v[8 * q + 4], v[8 * q + 5]); o.w = pk2(v[8 * q + 6], v[8 * q + 7]); *(LAS v4u*)(T + lane * 36 + 4 * q) = o; }
    LDS_WAIT(); asm volatile("" ::: "memory");
    const int c = lane & 7, r0 = lane >> 3;
#pragma unroll
    for (int i = 0; i < 8; ++i) { const int r = r0 + 8 * i; const v4u o = *(const LAS v4u*)(T + r * 36 + 4 * c); *(v4u*)(j.dst + (size_t)(n0 + r) * j.ldd + k0 + 8 * c) = o; }
    LDS_WAIT(); asm volatile("" ::: "memory");
}
constexpr int NJOBS = 62;
__device__ __forceinline__ CvtJob get_job(int jj, const Args& a) {
    CvtJob j; j.kind = 0; j.HO = 0; j.ks = nullptr; unsigned char* ws = a.ws;
    if (jj < 16) { const int l = jj >> 2, w = jj & 3, fi = 2 * l + (w >> 1);
        if ((w & 1) == 0) { j.W = a.in[w == 0 ? 8 : 12] + (size_t)l * D * NFF; j.ldw = NFF; j.K = D; j.Nd = NFF; j.kind = 1; j.HO = DFF; j.dst = (bf16*)(ws + WS_FIN + fi * SZ_FIN); j.ldd = D; j.ks = a.in[w == 0 ? 7 : 11] + l * D; }
        else { j.W = a.in[w == 1 ? 9 : 13] + (size_t)l * DFF * D; j.ldw = D; j.K = DFF; j.Nd = D; j.dst = (bf16*)(ws + WS_FOUT + fi * SZ_FOUT); j.ldd = DFF; } }
    else if (jj < 18) { const int e = jj - 16; j.W = a.in[14] + (size_t)e * D * DINE; j.ldw = DINE; j.K = D; j.Nd = DINE; j.dst = (bf16*)(ws + WS_EIN + e * SZ_EIN); j.ldd = D; j.ks = a.in[10] + (2 * e) * D; }
    else if (jj < 20) { const int e = jj - 18; j.W = a.in[24] + (size_t)e * D * D; j.ldw = D; j.K = D; j.Nd = D; j.dst = (bf16*)(ws + WS_EOUT + e * SZ_EOUT); j.ldd = D; }
    else if (jj < 22) { const int o = jj - 20; j.W = a.in[33] + (size_t)o * D * 4096; j.ldw = 4096; j.K = D; j.Nd = 4096; j.kind = 1; j.HO = 2048; j.dst = (bf16*)(ws + WS_GLU + o * SZ_GLU); j.ldd = D; }
    else if (jj < 30) { const int q = jj - 22, e = q >> 2, g = q & 3; j.W = a.in[15] + (size_t)(e * 4 + g) * 65536; j.ldw = 256; j.K = 256; j.Nd = 256; j.dst = (bf16*)(ws + WS_POOL + e * SZ_POOL) + (size_t)(g * 256) * 256; j.ldd = 256; }
    else { const int q = jj - 30, e = q >> 4, r = q & 15, isx = r >> 3, h = r & 7; j.W = a.in[isx ? 21 : 19] + (size_t)(e * 8 + h) * 16384; j.ldw = 128; j.K = 128; j.Nd = 128;
        j.dst = (bf16*)(ws + WS_GATE + e * SZ_GATE) + (size_t)(256 * h + 128 * isx) * 256 + (h & 1) * 128; j.ldd = 256; }
    return j;
}
__device__ const unsigned char CVT_JOBS[62] = { 0,      1, 22, 23, 24, 25, 26, 27, 28, 29, 30, 31, 32, 33, 34, 35, 36, 37, 38, 39, 40, 41, 42, 43, 44, 45, 46, 47, 48, 49, 50, 51, 52, 53, 54, 55, 56, 57, 58, 59, 60, 61,
                                                16, 18, 2, 3,      4, 5, 20,      6, 7,      8, 9, 17, 19,      10, 11,      12, 13, 21,      14, 15   };
__device__ const unsigned char CVT_STAGE_START[9] = { 0, 1, 46, 49, 51, 55, 57, 60, 62 };
__device__ __forceinline__ void cvt_stage(const Args& a, int stage, int widx, int nw, int lane, LAS unsigned* T) {
    int off = 0;
    for (int q = CVT_STAGE_START[stage]; q < CVT_STAGE_START[stage + 1]; ++q) { const CvtJob j = get_job(CVT_JOBS[q], a); const int nitems = (j.K >> 6) * (j.Nd >> 6);
        int first = widx - off; if (first < 0) first += nw;
        for (int it = first; it < nitems; it += nw) cvt_item(j, it, lane, T);
        off = (off + nitems) % nw; }
}
__device__ __forceinline__ void p0_prologue(const Args& a, LAS unsigned char* lds) {
    int tid = threadIdx.x; asm volatile("" : "+v"(tid)); const int lane = tid & 63, wave = __builtin_amdgcn_readfirstlane(tid >> 6);
    const int G = gridDim.x, gw = blockIdx.x * NWAVES + wave, NGW = G * NWAVES; unsigned char* ws = a.ws;
    cvt_stage(a, 0, gw, NGW, lane, (LAS unsigned*)(lds + RING_OFF + wave * 9216));
    { const int gt = blockIdx.x * NTHR + tid, NT = G * NTHR;
      for (int i = gt; i < 2 * 8 * 256 * 16; i += NT) { const int ch = i & 15, r = (i >> 4) & 255, h = (i >> 12) & 7, e = i >> 15;
          *(v4u*)((bf16*)(ws + WS_GATE + e * SZ_GATE) + (size_t)(256 * h + r) * 256 + ((h & 1) ^ 1) * 128 + ch * 8) = (v4u){0u, 0u, 0u, 0u}; }
      for (int i = (tid < 64 ? (int)blockIdx.x * 64 + tid : 2 * 128 * 64); i < 2 * 128 * 64; i += G * 64) { const int og = i >> 6, p = i & 63;
          const float lr = fminf(a.in[25][i], -1e-4f), li = a.in[26][i], dt = expf(a.in[27][og]);
          const float mag = expf(lr * dt), abr = mag * cosf(li * dt), abi = mag * sinf(li * dt), den = lr * lr + li * li, nr = abr - 1.0f;
          const float fre = (nr * lr + abi * li) / den, fim = (abi * lr - nr * li) / den;
          float* AB = (float*)(ws + WS_AB) + (size_t)i * 2; AB[0] = abr; AB[1] = abi;
          float* BB = (float*)(ws + WS_BB) + (size_t)i * 32; const float* br = a.in[28] + (size_t)i * 16; const float* bi = a.in[29] + (size_t)i * 16;
          float bre[16], bim[16];
#pragma unroll
          for (int c = 0; c < 16; ++c) { bre[c] = fre * br[c] - fim * bi[c]; bim[c] = fre * bi[c] + fim * br[c]; BB[c] = bre[c]; BB[16 + c] = bim[c]; }
          bf16* W1t = (bf16*)(ws + WS_W1) + (size_t)og * 128 * 256; float pr = 1.f, pi = 0.f;
          const int ppr_ = 2 * p, ppi_ = 2 * p + 1;
          for (int n = 0; n < 16; ++n) { const int s = 15 - n; v4u wr0, wr1, wi0, wi1;
              wr0.x = pk2(pr * bre[0] - pi * bim[0], pr * bre[1] - pi * bim[1]); wr0.y = pk2(pr * bre[2] - pi * bim[2], pr * bre[3] - pi * bim[3]); wr0.z = pk2(pr * bre[4] - pi * bim[4], pr * bre[5] - pi * bim[5]); wr0.w = pk2(pr * bre[6] - pi * bim[6], pr * bre[7] - pi * bim[7]);
              wr1.x = pk2(pr * bre[8] - pi * bim[8], pr * bre[9] - pi * bim[9]); wr1.y = pk2(pr * bre[10] - pi * bim[10], pr * bre[11] - pi * bim[11]); wr1.z = pk2(pr * bre[12] - pi * bim[12], pr * bre[13] - pi * bim[13]); wr1.w = pk2(pr * bre[14] - pi * bim[14], pr * bre[15] - pi * bim[15]);
              wi0.x = pk2(pr * bim[0] + pi * bre[0], pr * bim[1] + pi * bre[1]); wi0.y = pk2(pr * bim[2] + pi * bre[2], pr * bim[3] + pi * bre[3]); wi0.z = pk2(pr * bim[4] + pi * bre[4], pr * bim[5] + pi * bre[5]); wi0.w = pk2(pr * bim[6] + pi * bre[6], pr * bim[7] + pi * bre[7]);
              wi1.x = pk2(pr * bim[8] + pi * bre[8], pr * bim[9] + pi * bre[9]); wi1.y = pk2(pr * bim[10] + pi * bre[10], pr * bim[11] + pi * bre[11]); wi1.z = pk2(pr * bim[12] + pi * bre[12], pr * bim[13] + pi * bre[13]); wi1.w = pk2(pr * bim[14] + pi * bre[14], pr * bim[15] + pi * bre[15]);
              { const size_t fr_ = ((size_t)((ppr_ >> 5) * 2 + ((ppr_ >> 4) & 1)) * 8 + (s >> 1)) * 64, fi_ = ((size_t)((ppi_ >> 5) * 2 + ((ppi_ >> 4) & 1)) * 8 + (s >> 1)) * 64; const int q0_ = 2 * (s & 1);
                *(v4u*)(W1t + (fr_ + q0_ * 16 + (ppr_ & 15)) * 8) = wr0; *(v4u*)(W1t + (fr_ + (q0_ + 1) * 16 + (ppr_ & 15)) * 8) = wr1;
                *(v4u*)(W1t + (fi_ + q0_ * 16 + (ppi_ & 15)) * 8) = wi0; *(v4u*)(W1t + (fi_ + (q0_ + 1) * 16 + (ppi_ & 15)) * 8) = wi1; }
              const float npr = pr * abr - pi * abi, npi = pr * abi + pi * abr; pr = npr; pi = npi; } }
      for (int i = gt; i < 2 * 1024; i += NT) ((float*)(ws + WS_LS))[i] = -log1pf(expf(-a.in[23][i])); }
    bf16* Xb = (bf16*)(ws + WS_XB); pg8::rs_t* rs0 = (pg8::rs_t*)(ws + WS_RS);
    for (int m = gw; m < M; m += NGW) { const float* src = (m < MP) ? a.in[0] + (size_t)m * D : a.in[1] + (size_t)(m - MP) * D;
        float s = 0.f;
#pragma unroll
        for (int q = 0; q < 8; ++q) { const f32x4 v = *((const f32x4*)src + lane + 64 * q);
            v2u w; w.x = pk2(v[0], v[1]); w.y = pk2(v[2], v[3]); *((v2u*)(Xb + (size_t)m * D) + lane + 64 * q) = w;
            const float v0 = bf_lo(w.x), v1 = bf_hi(w.x), v2 = bf_lo(w.y), v3 = bf_hi(w.y); s += (v0 * v0 + v1 * v1) + (v2 * v2 + v3 * v3); }
        s = wave_sum(s); if (lane == 0) rs0[m] = (pg8::rs_t)(s * 1048576.0f + 0.5f); }
}

__device__ __forceinline__ void row_decode(int row, bool& isP, int& b, int& t, int& base) {
    if (row < MP) { isP = true; b = row >> 11; t = row & 2047; base = b << 11; } else { isP = false; const int q = row - MP; b = q >> 3; t = q & 7; base = MP + (b << 3); } }
__device__ __forceinline__ f32x4 ep_fetch(const bf16* Zc, int base, int tt, const float* st, int nbuf) {
    if (tt >= 0) { const v2u w = *(const v2u*)(Zc + (size_t)(base + tt) * 2048); return (f32x4){bf_lo(w.x), bf_hi(w.x), bf_lo(w.y), bf_hi(w.y)}; }
    if (st) return *(const f32x4*)(st + (size_t)(nbuf + tt) * 1024);
    return (f32x4){0.f, 0.f, 0.f, 0.f};
}
__device__ __forceinline__ f32x4 ep_cvt(v2u w) { return (f32x4){bf_lo(w.x), bf_hi(w.x), bf_lo(w.y), bf_hi(w.y)}; }
template <int W, bool FIRST>
__device__ __forceinline__ void ep_pool_fast(const bf16* Zr, bf16* Dr, float* ost, int t0) {
    v2u raw[31 + W];
#pragma unroll
    for (int i = 0; i < 31 + W; ++i) raw[i] = (FIRST && i < W - 1) ? (v2u){0u, 0u} : *(const v2u*)(Zr + (ptrdiff_t)(i - (W - 1)) * 2048);
    f32x4 s = (f32x4){0.f, 0.f, 0.f, 0.f};
    if (!FIRST) {
#pragma unroll
        for (int i = 0; i < W - 1; ++i) s += ep_cvt(raw[i]); }
#pragma unroll
    for (int k = 0; k < 32; ++k) { const f32x4 un = ep_cvt(raw[W - 1 + k]); s += un; const float inv = (FIRST && k + 1 < W) ? 1.0f / (float)(k + 1) : 1.0f / (float)W; const f32x4 d = (FIRST && k + 1 < W) ? s / (float)(k + 1) - un : s * inv - un;
        v2u o; o.x = pk2(d[0], d[1]); o.y = pk2(d[2], d[3]); *(v2u*)(Dr + (size_t)k * 1024) = o;
        if (!FIRST) { if (t0 + k >= SEQ - 15) *(f32x4*)(ost + (size_t)(t0 + k - (SEQ - 15)) * 1024) = un; }
        if (!(FIRST && k < W - 1)) s -= ep_cvt(raw[k]); }
}
template <int W>
__device__ __forceinline__ void ep_pool_sample(const bf16* Zr, bf16* Dr, const float* st, float* ost) {
    f32x4 pv[W - 1]; v2u raw[8]; f32x4 keep[7];
#pragma unroll
    for (int i = 0; i < W - 1; ++i) pv[i] = *(const f32x4*)(st + (size_t)(15 - (W - 1) + i) * 1024);
#pragma unroll
    for (int i = 0; i < 8; ++i) raw[i] = *(const v2u*)(Zr + (size_t)i * 2048);
#pragma unroll
    for (int i = 0; i < 7; ++i) keep[i] = *(const f32x4*)(st + (size_t)(8 + i) * 1024);
    f32x4 s = (f32x4){0.f, 0.f, 0.f, 0.f};
#pragma unroll
    for (int i = 0; i < W - 1; ++i) s += pv[i];
#pragma unroll
    for (int k = 0; k < 8; ++k) { const f32x4 un = ep_cvt(raw[k]); s += un; const f32x4 d = s / (float)W - un;
        v2u o; o.x = pk2(d[0], d[1]); o.y = pk2(d[2], d[3]); *(v2u*)(Dr + (size_t)k * 1024) = o;
        *(f32x4*)(ost + (size_t)(7 + k) * 1024) = un; if (k < 7) *(f32x4*)(ost + (size_t)k * 1024) = keep[k];
        s -= (k < W - 1) ? pv[k < W - 1 ? k : 0] : ep_cvt(raw[k - (W - 1) < 0 ? 0 : k - (W - 1)]); }
}
__device__ __forceinline__ void even_prep(const Args& a, int e) {
    int tid = threadIdx.x; asm volatile("" : "+v"(tid));
    unsigned char* ws = a.ws; const bf16* Z = (const bf16*)(ws + WS_Z); bf16* Dp = (bf16*)(ws + WS_DP); bf16* Cv = (bf16*)(ws + WS_CV);
    const float* spool = a.in[2] + (size_t)e * NBS * 15 * 1024; const float* sconv = a.in[3] + (size_t)e * NBS * 3 * 1024;
    const float* cw = a.in[17] + (size_t)e * 4 * 1024; const float* cb = a.in[18] + (size_t)e * 1024;
    float* o_poolp = a.out + O_POOLP + (size_t)e * NBP * 15 * 1024; float* o_pools = a.out + O_POOLS + (size_t)e * NBS * 15 * 1024;
    float* o_convp = a.out + O_CONVP + (size_t)e * NBP * 3 * 1024; float* o_convs = a.out + O_CONVS + (size_t)e * NBS * 3 * 1024;
    const int NT = gridDim.x * NTHR; constexpr int RUN = 32, NPR = (MP / RUN) * 512, NSR = NBS * 512;
    for (int idx = blockIdx.x * NTHR + tid; idx < NPR + NSR; idx += NT) {
        const bool isP = idx < NPR; const int r = isP ? idx : idx - NPR, q = r & 511, ck = r >> 9;
        const int b = isP ? (ck >> 6) : ck, t0 = isP ? (ck & 63) * RUN : 0, nrun = isP ? RUN : DSQ, base = isP ? b * SEQ : MP + b * DSQ;
        if (q < 256) {
            const int c = q * 4, w = 2 << (c >> 8); const bf16* Zc = Z + c; const float* st = isP ? nullptr : spool + (size_t)b * 15 * 1024 + c;
            { const bf16* Zr = Zc + (size_t)(base + t0) * 2048; bf16* Dr = Dp + (size_t)(base + t0) * 1024 + c;
              if (isP) { float* ost = o_poolp + (size_t)b * 15 * 1024 + c;
                if (t0 != 0) { if (w == 2) ep_pool_fast<2, false>(Zr, Dr, ost, t0); else if (w == 4) ep_pool_fast<4, false>(Zr, Dr, ost, t0); else if (w == 8) ep_pool_fast<8, false>(Zr, Dr, ost, t0); else ep_pool_fast<16, false>(Zr, Dr, ost, t0); }
                else { if (w == 2) ep_pool_fast<2, true>(Zr, Dr, ost, t0); else if (w == 4) ep_pool_fast<4, true>(Zr, Dr, ost, t0); else if (w == 8) ep_pool_fast<8, true>(Zr, Dr, ost, t0); else ep_pool_fast<16, true>(Zr, Dr, ost, t0); } }
              else { float* ost = o_pools + (size_t)b * 15 * 1024 + c;
                if (w == 2) ep_pool_sample<2>(Zr, Dr, st, ost); else if (w == 4) ep_pool_sample<4>(Zr, Dr, st, ost); else if (w == 8) ep_pool_sample<8>(Zr, Dr, st, ost); else ep_pool_sample<16>(Zr, Dr, st, ost); }
              continue; }
            f32x4 s = (f32x4){0.f, 0.f, 0.f, 0.f};
            for (int j = 1; j < w; ++j) s += ep_fetch(Zc, base, t0 - j, st, 15);
            for (int tb = 0; tb < nrun; tb += 8) { f32x4 un[8], uo[8];
#pragma unroll
                for (int k = 0; k < 8; ++k) { un[k] = ep_fetch(Zc, base, t0 + tb + k, st, 15); uo[k] = ep_fetch(Zc, base, t0 + tb + k - w + 1, st, 15); }
#pragma unroll
                for (int k = 0; k < 8; ++k) { const int t = t0 + tb + k; s += un[k];
                    const float cnt = isP ? (float)((t + 1) < w ? (t + 1) : w) : (float)w; const f32x4 d = s / cnt - un[k];
                    v2u o; o.x = pk2(d[0], d[1]); o.y = pk2(d[2], d[3]); *(v2u*)(Dp + (size_t)(base + t) * 1024 + c) = o;
                    if (isP) { if (t >= SEQ - 15) *(f32x4*)(o_poolp + ((size_t)b * 15 + (t - (SEQ - 15))) * 1024 + c) = un[k]; }
                    else { *(f32x4*)(o_pools + ((size_t)b * 15 + 7 + t) * 1024 + c) = un[k];
                           if (t < 7) *(f32x4*)(o_pools + ((size_t)b * 15 + t) * 1024 + c) = *(const f32x4*)(st + (size_t)(8 + t) * 1024); }
                    s -= uo[k]; } }
        } else {
            const int c = (q - 256) * 4; const bf16* Zc = Z + 1024 + c; const float* st = isP ? nullptr : sconv + (size_t)b * 3 * 1024 + c;
            const f32x4 w0 = *(const f32x4*)(cw + c), w1 = *(const f32x4*)(cw + 1024 + c), w2 = *(const f32x4*)(cw + 2048 + c), w3 = *(const f32x4*)(cw + 3072 + c), bias = *(const f32x4*)(cb + c);
            if (isP) { const bf16* Zr = Zc + (size_t)(base + t0) * 2048; bf16* Cr = Cv + (size_t)(base + t0) * 1024 + c; v2u raw[35]; const bool first = t0 == 0;
#pragma unroll
                for (int i = 0; i < 35; ++i) raw[i] = (i < 3 && first) ? (v2u){0u, 0u} : *(const v2u*)(Zr + (ptrdiff_t)(i - 3) * 2048);
#pragma unroll
                for (int k = 0; k < 32; ++k) { const f32x4 un = ep_cvt(raw[k + 3]); const f32x4 acc = bias + ep_cvt(raw[k]) * w0 + ep_cvt(raw[k + 1]) * w1 + ep_cvt(raw[k + 2]) * w2 + un * w3;
                    v2u o; o.x = pk2(acc[0], acc[1]); o.y = pk2(acc[2], acc[3]); *(v2u*)(Cr + (size_t)k * 1024) = o;
                    if (t0 + k >= SEQ - 3) *(f32x4*)(o_convp + ((size_t)b * 3 + (t0 + k - (SEQ - 3))) * 1024 + c) = un; }
                continue; }
            else { const bf16* Zr = Zc + (size_t)base * 2048; bf16* Cr = Cv + (size_t)base * 1024 + c; v2u raw[8];
                f32x4 p3 = *(const f32x4*)(st), p2 = *(const f32x4*)(st + 1024), p1 = *(const f32x4*)(st + 2048);
#pragma unroll
                for (int i = 0; i < 8; ++i) raw[i] = *(const v2u*)(Zr + (size_t)i * 2048);
#pragma unroll
                for (int k = 0; k < 8; ++k) { const f32x4 un = ep_cvt(raw[k]); const f32x4 acc = bias + p3 * w0 + p2 * w1 + p1 * w2 + un * w3;
                    v2u o; o.x = pk2(acc[0], acc[1]); o.y = pk2(acc[2], acc[3]); *(v2u*)(Cr + (size_t)k * 1024) = o;
                    if (k >= DSQ - 3) *(f32x4*)(o_convs + ((size_t)b * 3 + (k - (DSQ - 3))) * 1024 + c) = un;
                    p3 = p2; p2 = p1; p1 = un; }
                continue; }
            f32x4 p3 = ep_fetch(Zc, base, t0 - 3, st, 3), p2 = ep_fetch(Zc, base, t0 - 2, st, 3), p1 = ep_fetch(Zc, base, t0 - 1, st, 3);
            for (int tb = 0; tb < nrun; tb += 8) { f32x4 un[8];
#pragma unroll
                for (int k = 0; k < 8; ++k) un[k] = ep_fetch(Zc, base, t0 + tb + k, st, 3);
#pragma unroll
                for (int k = 0; k < 8; ++k) { const int t = t0 + tb + k; const f32x4 acc = bias + p3 * w0 + p2 * w1 + p1 * w2 + un[k] * w3;
                    v2u o; o.x = pk2(acc[0], acc[1]); o.y = pk2(acc[2], acc[3]); *(v2u*)(Cv + (size_t)(base + t) * 1024 + c) = o;
                    if (isP) { if (t >= SEQ - 3) *(f32x4*)(o_convp + ((size_t)b * 3 + (t - (SEQ - 3))) * 1024 + c) = un[k]; }
                    else if (t >= DSQ - 3) *(f32x4*)(o_convs + ((size_t)b * 3 + (t - (DSQ - 3))) * 1024 + c) = un[k];
                    p3 = p2; p2 = p1; p1 = un[k]; } }
        }
    }
}

__device__ __forceinline__ void even_scan(const Args& a, int e, LAS unsigned char* lds) {
    int tid = threadIdx.x; asm volatile("" : "+v"(tid));
    unsigned char* ws = a.ws; const unsigned* GAB = (const unsigned*)(ws + WS_GA); const bf16* UG = (const bf16*)(ws + WS_UGB); bf16* Y2 = (bf16*)(ws + WS_Y2);
    float* o_hp = a.out + O_HP + (size_t)e * NBP * 1024; float* o_hs = a.out + O_HS + (size_t)e * NBS * 1024; const float* h0s = a.in[4] + (size_t)e * NBS * 1024;
    const int G = gridDim.x; LAS float* car = (LAS float*)(lds + RING_OFF);
    const int ck = tid >> 4, cl = tid & 15;
    for (int it = blockIdx.x; it < NBP * 64; it += G) { const int b = (it >> 6) & 3, cb = 8 * (it & 7) + ((it >> 3) & 7), r0 = b * SEQ + ck * 64;
        const size_t ob = ((size_t)cb * M + r0) * 16 + cl; const unsigned* pg = GAB + ob; const bf16* pu = UG + ob;
        float av[64], bv[64];
#pragma unroll
        for (int t = 0; t < 64; ++t) { const unsigned w = pg[t * 16]; av[t] = bf_lo(w); bv[t] = bf_hi(w); }
        bf16 ugn[16];
#pragma unroll
        for (int k = 0; k < 16; ++k) ugn[k] = pu[k * 16];
        float A = 1.f, h = 0.f;
#pragma unroll
        for (int t = 0; t < 64; ++t) { av[t] = __expf(av[t]); h = av[t] * h + bv[t]; A *= av[t]; }
        car[(ck * 2 + 0) * 16 + cl] = A; car[(ck * 2 + 1) * 16 + cl] = h;
        LDS_WAIT(); __syncthreads();
        float c = 0.f;
#pragma unroll 8
        for (int j = 0; j < 32; ++j) { const float ca = car[(j * 2 + 0) * 16 + cl], ch = car[(j * 2 + 1) * 16 + cl]; c = j < ck ? ca * c + ch : c; }
        h = c; bf16* py = Y2 + (size_t)r0 * D + 1024 + cb * 16 + cl;
#pragma unroll
        for (int tb = 0; tb < 64; tb += 16) { float ug[16];
#pragma unroll
            for (int k = 0; k < 16; ++k) ug[k] = bf_lo((unsigned)ugn[k]);
            if (tb + 16 < 64) {
#pragma unroll
                for (int k = 0; k < 16; ++k) ugn[k] = pu[(tb + 16 + k) * 16]; }
#pragma unroll
            for (int k = 0; k < 16; ++k) { h = av[tb + k] * h + bv[tb + k]; *py = (bf16)pk2(h * gelu_tanh(ug[k]), 0.f); py += D; }
            asm volatile("" ::: "memory"); }
        if (ck == 31) o_hp[(size_t)b * 1024 + cb * 16 + cl] = h;
        __syncthreads(); }
    for (int idx = blockIdx.x * NTHR + tid; idx < NBS * 1024; idx += G * NTHR) { const int b = idx >> 10, ch = idx & 1023; float h = h0s[idx];
        const size_t ob = ((size_t)(ch >> 4) * M + MP + b * DSQ) * 16 + (ch & 15);
        unsigned gw[8]; float ug[8];
#pragma unroll
        for (int t = 0; t < DSQ; ++t) { gw[t] = GAB[ob + t * 16]; ug[t] = bf_lo((unsigned)UG[ob + t * 16]); }
#pragma unroll
        for (int t = 0; t < DSQ; ++t) { const int row = MP + b * DSQ + t; h = __expf(bf_lo(gw[t])) * h + bf_hi(gw[t]); Y2[(size_t)row * D + 1024 + ch] = (bf16)pk2(h * gelu_tanh(ug[t]), 0.f); }
        o_hs[idx] = h; }
}

constexpr int S5_BU_STRIDE = 132, S5_XS_STRIDE = 68, S5_WAVE_LDS = 16 * S5_BU_STRIDE * 4 + 16 * S5_XS_STRIDE * 4;
typedef short s5_bf16x8 __attribute__((ext_vector_type(8)));
__device__ __forceinline__ s5_bf16x8 s5_pack8(const float (&v)[8]) { v4u w; w.x = pk2(v[0], v[1]); w.y = pk2(v[2], v[3]); w.z = pk2(v[4], v[5]); w.w = pk2(v[6], v[7]); return __builtin_bit_cast(s5_bf16x8, w); }
__device__ __forceinline__ void s5_setup(const Args& a, int o, int g, int lane, s5_bf16x8 (&bbf)[8], s5_bf16x8 (&cmf)[4], s5_bf16x8& dmf, float (&gm8)[8], float& ar, float& ai) {
    unsigned char* ws = a.ws; const int og = o * 128 + g, tl = lane & 15, q = lane >> 4;
    const float* BB = (const float*)(ws + WS_BB);
#pragma unroll
    for (int nb = 0; nb < 8; ++nb) { float v[8];
#pragma unroll
        for (int j = 0; j < 8; ++j) v[j] = 0.f;
        if (q < 2) { const int pp = nb * 16 + tl; const float* s = BB + ((size_t)og * 64 + (pp >> 1)) * 32 + (pp & 1) * 16 + 8 * q; const f32x4 v0 = *(const f32x4*)s, v1 = *(const f32x4*)(s + 4);
            v[0] = v0[0]; v[1] = v0[1]; v[2] = v0[2]; v[3] = v0[3]; v[4] = v1[0]; v[5] = v1[1]; v[6] = v1[2]; v[7] = v1[3]; }
        bbf[nb] = s5_pack8(v); }
#pragma unroll
    for (int kb = 0; kb < 4; ++kb) { const size_t ci = ((size_t)og * 16 + tl) * 64 + kb * 16 + 4 * q; const f32x4 cr = *(const f32x4*)(a.in[30] + ci), cm = *(const f32x4*)(a.in[31] + ci);
        const float v[8] = {cr[0], -cm[0], cr[1], -cm[1], cr[2], -cm[2], cr[3], -cm[3]}; cmf[kb] = s5_pack8(v); }
    { const float dv = a.in[32][(size_t)o * D + g * 16 + tl]; float v[8];
#pragma unroll
      for (int j = 0; j < 8; ++j) v[j] = (q < 2 && 8 * q + j == tl) ? dv : 0.f;
      dmf = s5_pack8(v); }
#pragma unroll
    for (int j = 0; j < 8; ++j) gm8[j] = (q < 2) ? a.in[10][(size_t)(2 * o + 1) * D + g * 16 + 8 * q + j] : 0.f;
    const float* AB = (const float*)(ws + WS_AB) + ((size_t)og * 64 + lane) * 2; ar = AB[0]; ai = AB[1];
}
template <int MODE>
__device__ __forceinline__ void s5_run(const Args& a, int row0, int L, int g, const pg8::rs_t* rs, LAS unsigned char* wl, int lane,
                                       const s5_bf16x8 (&bbf)[8], const s5_bf16x8 (&cmf)[4], const s5_bf16x8& dmf, const float (&gm8)[8], float ar, float ai, float& xr, float& xi,
                                       const float* sin_re, const float* sin_im, float* sout_re, float* sout_im) {
    unsigned char* ws = a.ws; const bf16* X = (const bf16*)(ws + WS_XB); bf16* Y2 = (bf16*)(ws + WS_Y2);
    const int tl = lane & 15, q = lane >> 4; constexpr bool FULL = MODE != 0; constexpr size_t SSEQ = (size_t)NGRP * NST;
    LAS float* Bu = (LAS float*)wl; LAS unsigned* Xs = (LAS unsigned*)(wl + 16 * S5_BU_STRIDE * 4);
    const f32x4 zero4 = (f32x4){0.f, 0.f, 0.f, 0.f};
    const int nblk = (L + 15) >> 4;
    v4u xw[3]; float rv[3]; const v4u zw = (v4u){0u, 0u, 0u, 0u};
#pragma unroll
    for (int k = 0; k < 3; ++k) { xw[k] = zw; rv[k] = 1.f;
        if (q < 2 && 16 * k + tl < L) { xw[k] = *(const v4u*)(X + (size_t)(row0 + 16 * k + tl) * D + g * 16 + 8 * q); rv[k] = pg8::rs_get(rs[row0 + 16 * k + tl]); } }
    float n0r = 0.f, n0i = 0.f, n1r = 0.f, n1i = 0.f;
    if (MODE == 2) { n0r = sin_re[lane]; n0i = sin_im[lane]; n1r = sin_re[SSEQ + lane]; n1i = sin_im[SSEQ + lane]; }
#define S5_NEXT_BU(TN) do { \
        { const float rstd = pg8::rstd_of(rv[0], INV_D); const v4u x0 = xw[0]; const float v[8] = {bf_lo(x0.x) * rstd * gm8[0], bf_hi(x0.x) * rstd * gm8[1], bf_lo(x0.y) * rstd * gm8[2], bf_hi(x0.y) * rstd * gm8[3], bf_lo(x0.z) * rstd * gm8[4], bf_hi(x0.z) * rstd * gm8[5], bf_lo(x0.w) * rstd * gm8[6], bf_hi(x0.w) * rstd * gm8[7]}; \
          ufn = s5_pack8(v); } \
        xw[0] = xw[1]; rv[0] = rv[1]; xw[1] = xw[2]; rv[1] = rv[2]; xw[2] = zw; rv[2] = 1.f; \
        if (q < 2 && (TN) + 48 + tl < L) { xw[2] = *(const v4u*)(X + (size_t)(row0 + (TN) + 48 + tl) * D + g * 16 + 8 * q); rv[2] = pg8::rs_get(rs[row0 + (TN) + 48 + tl]); } \
        _Pragma("unroll") \
        for (int nb = 0; nb < 8; ++nb) { const f32x4 d = __builtin_amdgcn_mfma_f32_16x16x32_bf16(bbf[nb], ufn, zero4, 0, 0, 0); *(LAS f32x4*)(Bu + tl * S5_BU_STRIDE + nb * 16 + 4 * q) = d; }     \
    } while (0)
    s5_bf16x8 ufn;
    S5_NEXT_BU(0);
    for (int blk = 0; blk < nblk; ++blk) {
        const int t0 = blk * 16, nst = (L - t0) < 16 ? (L - t0) : 16;
        float s0r = 0.f, s0i = 0.f, s1r = 0.f, s1i = 0.f;
        if (MODE == 2) { s0r = n0r; s0i = n0i; s1r = n1r; s1i = n1i;
            if (blk + 1 < nblk) { n0r = sin_re[(size_t)(2 * blk + 2) * SSEQ + lane]; n0i = sin_im[(size_t)(2 * blk + 2) * SSEQ + lane]; n1r = sin_re[(size_t)(2 * blk + 3) * SSEQ + lane]; n1i = sin_im[(size_t)(2 * blk + 3) * SSEQ + lane]; } }
        const s5_bf16x8 uf = ufn;
        LDS_WAIT(); asm volatile("" ::: "memory");
        typedef float f32x2v __attribute__((ext_vector_type(2)));
        f32x2v bw[16];
#pragma unroll
        for (int t = 0; t < 16; ++t) bw[t] = *(const LAS f32x2v*)(Bu + t * S5_BU_STRIDE + 2 * lane);
        if (blk + 1 < nblk) S5_NEXT_BU(t0 + 16);
        f32x2v xs = (f32x2v){xr, xi}; const f32x2v aar = (f32x2v){ar, ar}, aai = (f32x2v){-ai, ai};
        if (MODE != 2 && nst == 16) {
#pragma unroll
            for (int t = 0; t < 16; ++t) { const f32x2v bb = bw[t]; xs = aar * xs + (aai * (f32x2v){xs.y, xs.x} + bb);
                if (FULL) Xs[t * S5_XS_STRIDE + lane] = pk2(xs.x, xs.y); } }
        else {
#pragma unroll
            for (int t = 0; t < 16; ++t) {
                if (MODE == 2) { if (t == 0) xs = (f32x2v){s0r, s0i}; if (t == 8) xs = (f32x2v){s1r, s1i}; }
                const f32x2v bb = bw[t]; const f32x2v nx = aar * xs + (aai * (f32x2v){xs.y, xs.x} + bb);
                if (t < nst) xs = nx;
                if (FULL) Xs[t * S5_XS_STRIDE + lane] = pk2(xs.x, xs.y);
                if (MODE == 2) { if (t == 7) { sout_re[(size_t)(2 * blk) * SSEQ + lane] = xs.x; sout_im[(size_t)(2 * blk) * SSEQ + lane] = xs.y; }
                                 if (t == 15) { sout_re[(size_t)(2 * blk + 1) * SSEQ + lane] = xs.x; sout_im[(size_t)(2 * blk + 1) * SSEQ + lane] = xs.y; } } } }
        xr = xs.x; xi = xs.y;
        LDS_WAIT(); asm volatile("" ::: "memory");
        if (FULL) {
            f32x4 y = zero4;
#pragma unroll
            for (int kb = 0; kb < 4; ++kb) { const s5_bf16x8 xf = *(const LAS s5_bf16x8*)(Xs + tl * S5_XS_STRIDE + kb * 16 + 4 * q); y = __builtin_amdgcn_mfma_f32_16x16x32_bf16(cmf[kb], xf, y, 0, 0, 0); }
            y = __builtin_amdgcn_mfma_f32_16x16x32_bf16(dmf, uf, y, 0, 0, 0);
            if (tl < nst) { v2u w; w.x = pk2(gelu_tanh(y[0]), gelu_tanh(y[1])); w.y = pk2(gelu_tanh(y[2]), gelu_tanh(y[3])); *(v2u*)(Y2 + (size_t)(row0 + t0 + tl) * D + g * 16 + 4 * q) = w; }
            asm volatile("" ::: "memory"); }
    }
}
#undef S5_NEXT_BU
__device__ __forceinline__ void s5_pass1(const Args& a, int o, int g, int row0, const pg8::rs_t* rs, LAS unsigned char* wl, int lane, float ar, float ai, float& xr, float& xi) {
    unsigned char* ws = a.ws; const bf16* X = (const bf16*)(ws + WS_XB); const int tl = lane & 15, q = lane >> 4, og = o * 128 + g;
    const bf16* W1 = (const bf16*)(ws + WS_W1) + (size_t)og * 128 * 256; LAS float* P1 = (LAS float*)wl;
    typedef float f32x2v __attribute__((ext_vector_type(2)));
    float gmb[8];
#pragma unroll
    for (int j = 0; j < 8; ++j) gmb[j] = a.in[10][(size_t)(2 * o + 1) * D + g * 16 + 8 * (q & 1) + j];
    v4u xw[8]; float rv[8];
#pragma unroll
    for (int ks = 0; ks < 8; ++ks) { const int row = row0 + 16 * tl + 2 * ks + (q >> 1); xw[ks] = *(const v4u*)(X + (size_t)row * D + g * 16 + 8 * (q & 1)); rv[ks] = pg8::rs_get(rs[row]); }
    s5_bf16x8 uf[8];
#pragma unroll
    for (int ks = 0; ks < 8; ++ks) { const float rstd = pg8::rstd_of(rv[ks], INV_D); const v4u x0 = xw[ks];
        const float v[8] = {bf_lo(x0.x) * rstd * gmb[0], bf_hi(x0.x) * rstd * gmb[1], bf_lo(x0.y) * rstd * gmb[2], bf_hi(x0.y) * rstd * gmb[3], bf_lo(x0.z) * rstd * gmb[4], bf_hi(x0.z) * rstd * gmb[5], bf_lo(x0.w) * rstd * gmb[6], bf_hi(x0.w) * rstd * gmb[7]};
        uf[ks] = s5_pack8(v); }
    for (int qt = 0; qt < 4; ++qt) {
        const bf16* W1q = W1 + (size_t)(qt * 2) * 8 * 64 * 8 + (size_t)lane * 8;
        s5_bf16x8 af[2][8];
#pragma unroll
        for (int mb = 0; mb < 2; ++mb)
#pragma unroll
            for (int ks = 0; ks < 8; ++ks) af[mb][ks] = *(const s5_bf16x8*)(W1q + (size_t)(mb * 8 + ks) * 512);
        f32x4 acc[2] = {(f32x4){0.f, 0.f, 0.f, 0.f}, (f32x4){0.f, 0.f, 0.f, 0.f}};
#pragma unroll
        for (int ks = 0; ks < 8; ++ks)
#pragma unroll
            for (int mb = 0; mb < 2; ++mb) acc[mb] = __builtin_amdgcn_mfma_f32_16x16x32_bf16(af[mb][ks], uf[ks], acc[mb], 0, 0, 0);
#pragma unroll
        for (int mb = 0; mb < 2; ++mb) *(LAS f32x4*)(P1 + tl * S5_BU_STRIDE + qt * 32 + mb * 16 + 4 * q) = acc[mb];
        asm volatile("" ::: "memory"); }
    LDS_WAIT(); asm volatile("" ::: "memory");
    float pr = ar, pi = ai;
#pragma unroll
    for (int k = 0; k < 4; ++k) { const float nr = pr * pr - pi * pi, ni = 2.0f * pr * pi; pr = nr; pi = ni; }
    f32x2v e[16];
#pragma unroll
    for (int b = 0; b < 16; ++b) e[b] = *(const LAS f32x2v*)(P1 + b * S5_BU_STRIDE + 2 * lane);
    f32x2v xs = (f32x2v){0.f, 0.f}; const f32x2v ppr = (f32x2v){pr, pr}, ppi = (f32x2v){-pi, pi};
#pragma unroll
    for (int b = 0; b < 16; ++b) xs = ppr * xs + (ppi * (f32x2v){xs.y, xs.x} + e[b]);
    xr = xs.x; xi = xs.y;
    LDS_WAIT(); asm volatile("" ::: "memory");
}
__device__ __forceinline__ void s5_phase(const Args& a, int o, const pg8::rs_t* rs, LAS unsigned char* lds) {
    int tid = threadIdx.x; asm volatile("" : "+v"(tid)); const int lane = tid & 63, wave = __builtin_amdgcn_readfirstlane(tid >> 6);
    const int G = gridDim.x; LAS unsigned char* wl = lds + RING_OFF + wave * S5_WAVE_LDS; LAS float* ends = (LAS float*)(lds + RING_OFF + NWAVES * S5_WAVE_LDS);
    s5_bf16x8 bbf[8], cmf[4], dmf; float gm8[8], ar, ai;
    for (int it = blockIdx.x; it < NBP * NGRP; it += G) {
        int b = it >> 7, g = it & 127;
        if (G == 256) { const int c = it & 255, k = it >> 8, x = c & 7, j = c >> 3; g = x * 16 + (j & 15); b = 2 * k + (j >> 4); }
        const int row0 = b * SEQ + wave * 256;
        { const float* AB = (const float*)(a.ws + WS_AB) + ((size_t)(o * 128 + g) * 64 + lane) * 2; ar = AB[0]; ai = AB[1]; }
        float xr = 0.f, xi = 0.f;
        s5_pass1(a, o, g, row0, rs, wl, lane, ar, ai, xr, xi);
        asm volatile("" ::: "memory");
        s5_setup(a, o, g, lane, bbf, cmf, dmf, gm8, ar, ai);
        ends[(wave * 2 + 0) * 64 + lane] = xr; ends[(wave * 2 + 1) * 64 + lane] = xi;
        float pr = ar, pi = ai;
#pragma unroll
        for (int k = 0; k < 8; ++k) { const float nr = pr * pr - pi * pi, ni = 2.0f * pr * pi; pr = nr; pi = ni; }
        LDS_WAIT(); __syncthreads();
        xr = 0.f; xi = 0.f;
        for (int j = 0; j < wave; ++j) { const float er = ends[(j * 2 + 0) * 64 + lane], ei = ends[(j * 2 + 1) * 64 + lane]; const float nr = pr * xr - pi * xi + er, ni = pr * xi + pi * xr + ei; xr = nr; xi = ni; }
        s5_run<1>(a, row0, 256, g, rs, wl, lane, bbf, cmf, dmf, gm8, ar, ai, xr, xi, nullptr, nullptr, nullptr, nullptr);
        if (wave == NWAVES - 1) { const size_t so = ((size_t)(o * NBP + b) * NGRP + g) * NST; a.out[O_REP + so + lane] = xr; a.out[O_IMP + so + lane] = xi; }
        __syncthreads(); }
    for (int it = blockIdx.x * NWAVES + wave; it < NGRP * (NBS / 8); it += G * NWAVES) { const int g = it & 127, b0 = (it >> 7) * 8; const size_t so = ((size_t)(o * NBS + b0) * NGRP + g) * NST;
        s5_setup(a, o, g, lane, bbf, cmf, dmf, gm8, ar, ai);
        float xr = 0.f, xi = 0.f;
        s5_run<2>(a, MP + b0 * DSQ, 8 * DSQ, g, rs, wl, lane, bbf, cmf, dmf, gm8, ar, ai, xr, xi, a.in[5] + so, a.in[6] + so, a.out + O_RES + so, a.out + O_IMS + so); }
}

template <int MODE>
__device__ __forceinline__ void splitk_fixup(const Args& a, const pg8::Gemm& g, int L0, int ntail, int nsplit, const pg8::rs_t* rs, pg8::rs_t* rsn, float alpha) {
    int tid = threadIdx.x; asm volatile("" : "+v"(tid)); const int lane = tid & 63, wave = __builtin_amdgcn_readfirstlane(tid >> 6);
    const int G = gridDim.x, gw = blockIdx.x * NWAVES + wave, NGW = G * NWAVES;
    bf16* Xb = (bf16*)(a.ws + WS_XB); bf16* Hb = (bf16*)(a.ws + WS_H); const bf16* P = (const bf16*)(a.ws + WS_PART);
    pg8::StaticOrder so; so.init(g, G, 0);
    if (MODE == 0 && nsplit == 8) {
        const int total = ntail * 256;
        for (int it0 = gw; it0 < total; it0 += 4 * NGW) { v2u p[4][8]; v2u xo[4]; size_t off[4]; int row[4]; bool ok[4];
#pragma unroll
            for (int k = 0; k < 4; ++k) { const int it = it0 + k * NGW; ok[k] = it < total; const int itc = ok[k] ? it : it0; const int ti = itc >> 8, r = itc & 255; pg8::Unit u; so.tile_of(L0 + ti, u);
                row[k] = u.pm * 256 + r; off[k] = (size_t)row[k] * D + u.pn * 256 + 4 * lane; xo[k] = *(const v2u*)(Xb + off[k]);
#pragma unroll
                for (int sp = 0; sp < 8; ++sp) p[k][sp] = *(const v2u*)(P + (size_t)(sp * ntail + ti) * 65536 + r * 256 + 4 * lane); }
#pragma unroll
            for (int k = 0; k < 4; ++k) { float s0 = 0.f, s1 = 0.f, s2 = 0.f, s3 = 0.f;
#pragma unroll
                for (int sp = 0; sp < 8; ++sp) { s0 += bf_lo(p[k][sp].x); s1 += bf_hi(p[k][sp].x); s2 += bf_lo(p[k][sp].y); s3 += bf_hi(p[k][sp].y); }
                v2u w; w.x = pk2(bf_lo(xo[k].x) + s0 * alpha, bf_hi(xo[k].x) + s1 * alpha); w.y = pk2(bf_lo(xo[k].y) + s2 * alpha, bf_hi(xo[k].y) + s3 * alpha);
                const float v0 = bf_lo(w.x), v1 = bf_hi(w.x), v2 = bf_lo(w.y), v3 = bf_hi(w.y); const float ss = wave_sum((v0 * v0 + v1 * v1) + (v2 * v2 + v3 * v3));
                if (ok[k]) { *(v2u*)(Xb + off[k]) = w; if (lane == 0) pg8::rs_add(rsn + row[k], ss); } } }
        return; }
    for (int it = gw; it < ntail * 256; it += NGW) { const int ti = it >> 8, r = it & 255; pg8::Unit u; so.tile_of(L0 + ti, u); const int row = u.pm * 256 + r;
        if (MODE == 0) { const int col = u.pn * 256 + 4 * lane; float s0 = 0.f, s1 = 0.f, s2 = 0.f, s3 = 0.f;
            for (int sp = 0; sp < nsplit; ++sp) { const v2u p = *(const v2u*)(P + (size_t)(sp * ntail + ti) * 65536 + r * 256 + 4 * lane); s0 += bf_lo(p.x); s1 += bf_hi(p.x); s2 += bf_lo(p.y); s3 += bf_hi(p.y); }
            const size_t off = (size_t)row * D + col; const v2u xo = *(const v2u*)(Xb + off);
            v2u w; w.x = pk2(bf_lo(xo.x) + s0 * alpha, bf_hi(xo.x) + s1 * alpha); w.y = pk2(bf_lo(xo.y) + s2 * alpha, bf_hi(xo.y) + s3 * alpha); *(v2u*)(Xb + off) = w;
            const float v0 = bf_lo(w.x), v1 = bf_hi(w.x), v2 = bf_lo(w.y), v3 = bf_hi(w.y);
            const float ss = wave_sum((v0 * v0 + v1 * v1) + (v2 * v2 + v3 * v3)); if (lane == 0) pg8::rs_add(rsn + row, ss); }
        else { float a0 = 0.f, a1 = 0.f, b0 = 0.f, b1 = 0.f;
            for (int sp = 0; sp < nsplit; ++sp) { const bf16* p = P + (size_t)(sp * ntail + ti) * 65536 + r * 256 + 2 * lane; const unsigned p1 = *(const unsigned*)p, p2 = *(const unsigned*)(p + 128); a0 += bf_lo(p1); a1 += bf_hi(p1); b0 += bf_lo(p2); b1 += bf_hi(p2); }
            if (MODE == 1) { const float rstd = pg8::rstd_of(pg8::rs_get(rs[row]), INV_D); const float g0 = a0 * rstd, g1 = a1 * rstd;
                *(unsigned*)(Hb + (size_t)row * DFF + u.pn * 128 + 2 * lane) = pk2(g0 * pg8::sigmoidf_fast(g0) * (b0 * rstd), g1 * pg8::sigmoidf_fast(g1) * (b1 * rstd)); }
            else { const size_t off = (size_t)row * D + u.pn * 128 + 2 * lane; const unsigned xo = *(const unsigned*)(Xb + off);
                const unsigned w = pk2(bf_lo(xo) + a0 * pg8::sigmoidf_fast(b0), bf_hi(xo) + a1 * pg8::sigmoidf_fast(b1)); *(unsigned*)(Xb + off) = w;
                const float v0 = bf_lo(w), v1 = bf_hi(w); const float ss = wave_sum(v0 * v0 + v1 * v1); if (lane == 0) pg8::rs_add(rsn + row, ss); } }
    }
}

__device__ __forceinline__ void final_norm(const Args& a, const pg8::rs_t* rs) {
    int tid = threadIdx.x; asm volatile("" : "+v"(tid)); const int lane = tid & 63, wave = __builtin_amdgcn_readfirstlane(tid >> 6);
    const bf16* Xb = (const bf16*)(a.ws + WS_XB); const float* gn = a.in[34]; const int gw = blockIdx.x * NWAVES + wave, NGW = gridDim.x * NWAVES;
    for (int m = gw; m < M; m += NGW) { const float rstd = pg8::rstd_of(pg8::rs_get(rs[m]), INV_D); float* dst = (m < MP) ? a.out + O_YP + (size_t)m * D : a.out + O_YS + (size_t)(m - MP) * D;
#pragma unroll
        for (int q = 0; q < 8; ++q) { const v2u x = *((const v2u*)(Xb + (size_t)m * D) + lane + 64 * q); const f32x4 gq = *((const f32x4*)gn + lane + 64 * q);
            *((f32x4*)dst + lane + 64 * q) = (f32x4){bf_lo(x.x) * rstd * gq[0], bf_hi(x.x) * rstd * gq[1], bf_lo(x.y) * rstd * gq[2], bf_hi(x.y) * rstd * gq[3]}; } }
}

#ifndef PH_MASK
#define PH_MASK 0xFFF
#endif
#ifndef MK_PER_PHASE
#define MK_PER_PHASE 0
#endif
__global__ void __launch_bounds__(NTHR, 2) mk_fwd(Args a) {
    extern __shared__ __attribute__((aligned(16))) unsigned char lds_raw[];
    LAS unsigned char* lds = (LAS unsigned char*)lds_raw;
    const int tid = threadIdx.x, G = gridDim.x;
    volatile LAS unsigned* MISC = (volatile LAS unsigned*)(lds + MISC_OFF);
    for (int u = tid; u < (LDS_BYTES - LDSCTL_OFF) / 4; u += NTHR) ((LAS unsigned*)(lds + LDSCTL_OFF))[u] = 0u;
    __syncthreads();
    unsigned char* ws = a.ws;
    unsigned* ctl = (unsigned*)(ws + WS_CTL);
    const int lo = a.lo, hi = a.hi;
    XcdBarrier bar; bar.bar = ctl + CW_BAR; bar.x = 0; bar.st = nullptr;
    if (hi - lo > 1) bar = xcd_barrier_post(ctl + CW_BAR, MISC + 8);
    bf16* Xb = (bf16*)(ws + WS_XB); pg8::rs_t* RS = (pg8::rs_t*)(ws + WS_RS); bf16* Hb = (bf16*)(ws + WS_H);
    bf16* Z = (bf16*)(ws + WS_Z); bf16* Dp = (bf16*)(ws + WS_DP); bf16* Cv = (bf16*)(ws + WS_CV);
    unsigned* GAB = (unsigned*)(ws + WS_GA); bf16* Y2 = (bf16*)(ws + WS_Y2);
    int pc = 0;
#define ON() (pc >= lo && pc < hi)
#define SEAM() do { if (pc >= lo && pc + 1 < hi) xcd_barrier(bar); ++pc; } while (0)
#define GEMM_PHASE(EPI, g, E) do { pg8::StaticOrder S_; S_.init(g, G, (int)blockIdx.x); pg8::gemm_phase<EPI, pg8::StaticOrder, true, true>(lds + RING_OFF, g, S_, E); } while (0)

#define GEMM_TAIL_PHASE(EPI, MODE, g, E, NFULL, rs_, rsn_, alpha_) do { \
        const int nun_ = ((g).M / 256) * ((g).N / 256), ntail_ = nun_ - (NFULL) * G, npairs_ = (g).K / 128; \
        const bool split_ = ntail_ > 0 && ntail_ <= G; int nsplit_ = split_ ? G / ntail_ : 1; if (nsplit_ > npairs_ / 2) nsplit_ = npairs_ / 2; \
        if (ON()) { { pg8::StaticOrder S_; S_.init(g, G, (int)blockIdx.x, split_ ? (NFULL) : (1 << 30)); pg8::gemm_phase<EPI, pg8::StaticOrder, true, true>(lds + RING_OFF, g, S_, E); } \
            if (split_) { const pg8::EpiPartial EP_{(bf16*)(ws + WS_PART)}; pg8::SplitTailOrder T_; T_.init(g, G, (int)blockIdx.x, (NFULL) * G, ntail_, nsplit_); pg8::gemm_phase<pg8::EpiPartial, pg8::SplitTailOrder, true, true>(lds + RING_OFF, g, T_, EP_); } } \
        SEAM(); \
        if (split_) { if (ON()) splitk_fixup<MODE>(a, g, (NFULL) * G, ntail_, nsplit_, rs_, rsn_, alpha_); \
            SEAM(); } } while (0)

    if (ON()) if constexpr ((PH_MASK >> 0) & 1) { p0_prologue(a, lds); }
    SEAM();
    int fi = 0;
    for (int l = 0; l <= 4; ++l) {
        const int nrep = (l == 0 || l == 4) ? 1 : 2;
        for (int rep = 0; rep < nrep; ++rep, ++fi) {
            const int xv = fi + ((fi + 1) >> 1);
            const int dk = (G != 256 || fi == 0) ? 0 : ((fi & 1) == 0 ? 1 : ((fi & 3) == 1 ? 2 : 3));
            const bool defer_this = (G == 256) && (fi == 1 || fi == 3 || fi == 5);
            { const pg8::Gemm g{Xb, (const bf16*)(ws + WS_FIN + (size_t)fi * SZ_FIN), M, NFF, D, D, 0, 0}; const pg8::EpiSwiglu E{Hb, DFF, RS + (size_t)xv * M, INV_D};
              const int GG = (G == 256) ? 224 : G, nrounds = ((M / 256) * (NFF / 256) + GG - 1) / GG;
              {
                if (ON()) if constexpr ((PH_MASK >> 1) & 1) {
                    unsigned* dflag = ctl + CW_FLAG + 64 * fi;
                    if (GG == G && fi + 1 < 8) { int tid3 = threadIdx.x; asm volatile("" : "+v"(tid3)); const int w3 = __builtin_amdgcn_readfirstlane(tid3 >> 6); cvt_stage(a, fi + 1, (int)blockIdx.x * NWAVES + w3, G * NWAVES, tid3 & 63, (LAS unsigned*)(lds + RING_OFF + w3 * 9216)); __syncthreads(); }
                    if ((int)blockIdx.x < GG) { pg8::SeqOrder S_; S_.init(g, MP / 256, GG, (int)blockIdx.x, 0, nrounds); if (dk) { S_.flag = dflag; S_.target = (unsigned)(G - GG); } pg8::gemm_phase<pg8::EpiSwiglu, pg8::SeqOrder, true, true>(lds + RING_OFF, g, S_, E); }
                    else {
                      if (dk) { const int c2 = (int)blockIdx.x - GG, lm = (fi - 1) >> 1;
                        if (dk == 3) { const pg8::Gemm g2{Y2, (const bf16*)(ws + WS_GLU + (size_t)(lm >> 1) * SZ_GLU), M, 4096, D, D, 0, 0}; const pg8::EpiGlu E2{Xb, RS + (size_t)xv * M};
                            const pg8::FewUnitsOrder O_{MP / 256, MS / 256, 16, 2 * c2, 2, D}; pg8::gemm_phase<pg8::EpiGlu, pg8::FewUnitsOrder, true, true>(lds + RING_OFF, g2, O_, E2); }
                        else { const pg8::Gemm g2{dk == 1 ? Hb : Y2, dk == 1 ? (const bf16*)(ws + WS_FOUT + (size_t)(fi - 1) * SZ_FOUT) : (const bf16*)(ws + WS_EOUT + (size_t)(lm >> 1) * SZ_EOUT), M, D, dk == 1 ? DFF : D, dk == 1 ? DFF : D, 0, 0};
                            const pg8::EpiResid E2{Xb, RS + (size_t)xv * M, dk == 1 ? 0.5f : 1.0f};
                            const pg8::FewUnitsOrder O_{MP / 256, MS / 256, 8, c2, 1, g2.K}; pg8::gemm_phase<pg8::EpiResid, pg8::FewUnitsOrder, true, true>(lds + RING_OFF, g2, O_, E2); }
                        asm volatile("s_waitcnt vmcnt(0)" ::: "memory"); __syncthreads();
                        if (threadIdx.x == 0) { __builtin_amdgcn_fence(__ATOMIC_RELEASE, "agent"); asm volatile("s_waitcnt vmcnt(0)" ::: "memory"); (void)xb_add(dflag, 1u); } }
                      if (fi + 1 < 8) { int tid2 = threadIdx.x; asm volatile("" : "+v"(tid2)); const int w2 = __builtin_amdgcn_readfirstlane(tid2 >> 6); cvt_stage(a, fi + 1, ((int)blockIdx.x - GG) * NWAVES + w2, (G - GG) * NWAVES, tid2 & 63, (LAS unsigned*)(lds + RING_OFF + w2 * 9216)); } } }
                SEAM(); } }
            if constexpr ((PH_MASK >> 2) & 1) { const pg8::Gemm g{Hb, (const bf16*)(ws + WS_FOUT + (size_t)fi * SZ_FOUT), defer_this ? MP : M, D, DFF, DFF, 0, 0}; const pg8::EpiResid E{Xb, RS + (size_t)(xv + 1) * M, 0.5f};
              GEMM_TAIL_PHASE(pg8::EpiResid, 0, g, E, (((g).M / 256) * (D / 256)) / G, (const pg8::rs_t*)nullptr, RS + (size_t)(xv + 1) * M, 0.5f); }
        }
        if (l < 4) {
            const int xv = 3 * l + 1;
            if ((l & 1) == 0) { const int e = l >> 1;
                if (ON()) { const pg8::Gemm g{Xb, (const bf16*)(ws + WS_EIN + (size_t)e * SZ_EIN), M, DINE, D, D, 0, 0}; const pg8::EpiZ E{Z, 2048, RS + (size_t)xv * M, INV_D, (bf16*)(ws + WS_UGB), M}; if constexpr ((PH_MASK >> 3) & 1) { GEMM_PHASE(pg8::EpiZ, g, E); } }
                SEAM();
                if (ON()) if constexpr ((PH_MASK >> 4) & 1) { even_prep(a, e); }
                SEAM();
                if (ON()) { { const pg8::Gemm g{Cv, (const bf16*)(ws + WS_GATE + (size_t)e * SZ_GATE), M, 2048, 256, 1024, 1, 256};
                              const pg8::EpiGate E{Cv, a.in[20] + e * 1024, a.in[22] + e * 1024, (const float*)(ws + WS_LS) + e * 1024, GAB, M}; if constexpr ((PH_MASK >> 5) & 1) { GEMM_PHASE(pg8::EpiGate, g, E); } }
                            { const pg8::Gemm g{Dp, (const bf16*)(ws + WS_POOL + (size_t)e * SZ_POOL), M, 1024, 256, 1024, 0, 256};
                              const pg8::EpiPool E{Y2, D, a.in[16] + e * 1024}; if constexpr ((PH_MASK >> 6) & 1) { pg8::StaticOrder S_; S_.init(g, G, G - 1 - (int)blockIdx.x); pg8::gemm_phase<pg8::EpiPool, pg8::StaticOrder, true, true>(lds + RING_OFF, g, S_, E); } } }
                SEAM();
                if (ON()) if constexpr ((PH_MASK >> 7) & 1) { even_scan(a, e, lds); }
                SEAM();
                if (ON()) if constexpr ((PH_MASK >> 8) & 1) { const pg8::Gemm g{Y2, (const bf16*)(ws + WS_EOUT + (size_t)e * SZ_EOUT), (G == 256) ? MP : M, D, D, D, 0, 0}; const pg8::EpiResid E{Xb, RS + (size_t)(xv + 1) * M, 1.0f}; GEMM_PHASE(pg8::EpiResid, g, E); }
                SEAM();
            } else { const int o = l >> 1;
                if (ON()) if constexpr ((PH_MASK >> 9) & 1) { s5_phase(a, o, RS + (size_t)xv * M, lds); }
                SEAM();
                if (ON()) if constexpr ((PH_MASK >> 10) & 1) { const pg8::Gemm g{Y2, (const bf16*)(ws + WS_GLU + (size_t)o * SZ_GLU), (G == 256) ? MP : M, 4096, D, D, 0, 0}; const pg8::EpiGlu E{Xb, RS + (size_t)(xv + 1) * M}; GEMM_PHASE(pg8::EpiGlu, g, E); }
                SEAM();
            }
        }
    }
    if (ON()) if constexpr ((PH_MASK >> 11) & 1) { final_norm(a, RS + (size_t)12 * M); }
#undef ON
#undef SEAM
#undef GEMM_PHASE
#undef GEMM_TAIL_PHASE
}
constexpr int N_PHASES = 1000;

extern "C" void kernel_launch(void* const* d_in, const int* in_sizes, int n_in, void* d_out, int out_size, void* d_ws, size_t ws_size, hipStream_t stream) {
    static int grid = 0;
    if (grid == 0) {
        if (n_in != 35 || (size_t)out_size != O_END || ws_size < WS_END) { fprintf(stderr, "kernel_launch: built for 35 inputs, %zu outputs, >= %zu bytes of workspace; got n_in %d, out %d, ws %zu; nothing launched\n", (size_t)O_END, (size_t)WS_END, n_in, out_size, ws_size); grid = -1; return; }
        int dev = 0, cus = 0, per_cu = 0;
        if (hipGetDevice(&dev) != hipSuccess || hipDeviceGetAttribute(&cus, hipDeviceAttributeMultiprocessorCount, dev) != hipSuccess) { fprintf(stderr, "kernel_launch: device query failed\n"); grid = -1; return; }
        if (hipFuncSetAttribute((const void*)mk_fwd, hipFuncAttributeMaxDynamicSharedMemorySize, LDS_BYTES) != hipSuccess) { fprintf(stderr, "kernel_launch: hipFuncSetAttribute failed\n"); grid = -1; return; }
        if (hipOccupancyMaxActiveBlocksPerMultiprocessor(&per_cu, (const void*)mk_fwd, NTHR, LDS_BYTES) != hipSuccess || per_cu < 1) { fprintf(stderr, "kernel_launch: occupancy query says %d workgroups per CU\n", per_cu); }
        (void)hipGetLastError();
        grid = cus;
    }
    if (grid < 0) return;
    if (hipMemsetAsync((char*)d_ws + WS_CTL, 0, CTL_ZERO_BYTES, stream) != hipSuccess) { fprintf(stderr, "kernel_launch: memset failed\n"); return; }
    Args a; memset(&a, 0, sizeof(a));
    for (int i = 0; i < 35; ++i) a.in[i] = (const float*)d_in[i];
    a.out = (float*)d_out; a.ws = (unsigned char*)d_ws;
#if MK_PER_PHASE
    for (int ph = 0; ph < N_PHASES; ++ph) { a.lo = ph; a.hi = ph + 1; hipLaunchKernelGGL(mk_fwd, dim3(grid), dim3(NTHR), LDS_BYTES, stream, a); }
#else
    a.lo = 0; a.hi = N_PHASES; hipLaunchKernelGGL(mk_fwd, dim3(grid), dim3(NTHR), LDS_BYTES, stream, a);
#endif
    const hipError_t le = hipPeekAtLastError();
    if (le != hipSuccess) fprintf(stderr, "kernel_launch: launch failed: %s\n", hipGetErrorName(le));
}
```

```cpp
#include <hip/hip_runtime.h>
#include <cstdio>
#include <cstdint>
#include <cstring>
namespace pg8 {
#define PG8_LAS __attribute__((address_space(3)))
typedef unsigned short bf16_t;
typedef short bf16x8 __attribute__((ext_vector_type(8)));
typedef float f32x4 __attribute__((ext_vector_type(4)));
typedef unsigned u32x4 __attribute__((ext_vector_type(4)));
constexpr int BM = 256, BK = 64, HALF = 128, HTB = HALF * BK * 2  , STAGE_BYTES = 8 * HTB, NXCD = 8, WGM = 8;

__host__ __device__ __forceinline__ int lds_byte(int r, int c) { const int st = (r >> 4) * 2 + (c >> 5), rr = r & 15, cc = c & 31, ob = rr * 64 + cc * 2; return st * 1024 + (ob ^ (((ob >> 9) & 1) << 5)); }
__host__ __device__ __forceinline__ void stage_rc(int b, int& R, int& C) { const int st = b / 1024, sb = b % 1024, swz = sb ^ (((sb >> 9) & 1) << 5); R = (st >> 1) * 16 + swz / 64; C = (st & 1) * 32 + (swz % 64) / 2; }
__host__ __device__ __forceinline__ int perm32(int rho) { const int n = rho >> 4, i = rho & 15; return 8 * (i >> 2) + 4 * n + (i & 3); }

struct Unit { int pm, pn, ka, kb, nt, aux; };
struct Gemm { const bf16_t* A; const bf16_t* Bt; int M, N, K, lda, ak_shift, ak_mul; };

struct StaticOrder {
    int nM, nN, nwg, G, c, imax, K, ak_shift, ak_mul;
    __host__ __device__ void init(const Gemm& g, int G_, int c_, int imax_ = 1 << 30) { nM = g.M / BM; nN = g.N / BM; nwg = nM * nN; G = G_; c = c_; imax = imax_; K = g.K; ak_shift = g.ak_shift; ak_mul = g.ak_mul; }
    __host__ __device__ void tile_of(int L, Unit& u) const {
        int wgid = L; { const int q = nwg / NXCD, r = nwg % NXCD, xcd = wgid % NXCD, off = wgid / NXCD; wgid = (xcd < r ? xcd * (q + 1) : r * (q + 1) + (xcd - r) * q) + off; }
        const int nig = WGM * nN, gid = wgid / nig, fm = gid * WGM, gsz = (nM - fm) < WGM ? (nM - fm) : WGM;
        u.pm = fm + ((wgid % nig) % gsz); u.pn = (wgid % nig) / gsz; }
    __host__ __device__ bool next(int i, Unit& u) const {
        const long L = (long)i * G + c; if (L >= nwg || i >= imax) return false;
        tile_of((int)L, u); u.ka = (u.pn >> ak_shift) * ak_mul; u.kb = 0; u.nt = K / BK; u.aux = 0; return true;
    }
    __device__ __forceinline__ void a_ready(const Unit&, int) const {}
    __device__ __forceinline__ void done(const Unit&) const {}
};
struct SplitTailOrder {
    StaticOrder so; int L0, ntail, nsplit, npairs;
    __host__ __device__ void init(const Gemm& g, int G_, int c_, int L0_, int ntail_, int nsplit_) { so.init(g, G_, c_); L0 = L0_; ntail = ntail_; nsplit = nsplit_; npairs = g.K / (2 * BK); }
    __host__ __device__ bool next(int i, Unit& u) const {
        if (i != 0 || so.c >= ntail * nsplit) return false;
        const int ti = so.c % ntail, s = so.c / ntail, p0 = (s * npairs) / nsplit, p1 = ((s + 1) * npairs) / nsplit;
        so.tile_of(L0 + ti, u); u.ka = p0 * 2 * BK; u.kb = u.ka; u.nt = 2 * (p1 - p0); u.aux = s * ntail + ti; return true;
    }
    __device__ __forceinline__ void a_ready(const Unit&, int) const {}
    __device__ __forceinline__ void done(const Unit&) const {}
};

struct SeqOrder {
    StaticOrder so, ss; int G, c, i0, i1, npu, nsu, npm, nsm, K; unsigned* flag; unsigned target;
    __host__ __device__ void init(const Gemm& g, int npanels_first, int G_, int c_, int i0_, int i1_) { Gemm gp = g; gp.M = npanels_first * BM; so.init(gp, G_, c_); gp.M = g.M - npanels_first * BM; ss.init(gp, G_, c_); G = G_; c = c_; i0 = i0_; i1 = i1_;
        npm = npanels_first; nsm = g.M / BM - npanels_first; npu = npm * (g.N / BM); nsu = nsm * (g.N / BM); K = g.K; flag = nullptr; target = 0u; }
    __host__ __device__ bool next(int i, Unit& u) const {
        const int ii = i0 + i; if (ii >= i1) return false; const int s = ii * G + c;
        if (s < npu) so.tile_of(s, u); else { const int j = s - npu; if (j >= nsu) return false; ss.tile_of(j, u); u.pm += npm; }
        u.ka = 0; u.kb = 0; u.nt = K / BK; u.aux = 0; return true; }
    __device__ __forceinline__ void a_ready(const Unit& u, int wid) const { if (flag != nullptr && u.pm >= npm && wid == 0) { unsigned sp_ = 0u;
            while (__hip_atomic_load(flag, __ATOMIC_RELAXED, __HIP_MEMORY_SCOPE_AGENT) < target) { __builtin_amdgcn_s_sleep(2); if (++sp_ > (1u << 22)) break; }
            __builtin_amdgcn_fence(__ATOMIC_ACQUIRE, "agent"); asm volatile("s_waitcnt vmcnt(0)" ::: "memory"); } }
    __device__ __forceinline__ void done(const Unit&) const {}
};
struct FewUnitsOrder { int pm0, npm, nN, first, cnt, K;
    __host__ __device__ bool next(int i, Unit& u) const { if (i >= cnt) return false; const int t = first + i; u.pm = pm0 + t % npm; u.pn = t / npm; u.ka = 0; u.kb = 0; u.nt = K / BK; u.aux = 0; return true; }
    __device__ __forceinline__ void a_ready(const Unit&, int) const {}
    __device__ __forceinline__ void done(const Unit&) const {}
};

__device__ __forceinline__ unsigned cvt_pk_bf16(float lo, float hi) { unsigned r; asm volatile("v_cvt_pk_bf16_f32 %0, %1, %2" : "=v"(r) : "v"(lo), "v"(hi)); return r; }
typedef float f32x2 __attribute__((ext_vector_type(2)));
typedef unsigned u32x2 __attribute__((ext_vector_type(2)));
constexpr float RMS_EPS = 1e-6f;
typedef unsigned long long rs_t;
__device__ __forceinline__ void rs_add(rs_t* p, float ss) { atomicAdd(p, (rs_t)(ss * 1048576.0f + 0.5f)); }
__device__ __forceinline__ float rs_get(rs_t v) { return (float)v * (1.0f / 1048576.0f); }
__device__ __forceinline__ float bf_lo(unsigned u) { return __builtin_bit_cast(float, u << 16); }
__device__ __forceinline__ float bf_hi(unsigned u) { return __builtin_bit_cast(float, u & 0xffff0000u); }
__device__ __forceinline__ float sigmoidf_fast(float x) { return __builtin_amdgcn_rcpf(1.0f + __expf(-x)); }
__device__ __forceinline__ float rstd_of(float sumsq, float inv_n) { return __builtin_amdgcn_rsqf(sumsq * inv_n + RMS_EPS); }

struct EpiSwiglu {
    static constexpr bool PERM = true, AFTER_DRAIN = false;
    bf16_t* H; int ldh; const rs_t* rs; float inv_n;
    __device__ __forceinline__ void operator()(const f32x4 (&acc)[2][2][4][2], const Unit& u, int wr, int wc, int fr, int fq) const {
        const int row0 = u.pm * BM + wr * 64 + fr, col0 = u.pn * HALF + wc * 32 + 8 * fq;
#pragma unroll
        for (int ai = 0; ai < 2; ++ai)
#pragma unroll
            for (int m = 0; m < 4; ++m) { const int row = row0 + ai * HALF + m * 16;
                const float ms = rs_get(rs[row]) * inv_n + RMS_EPS, c2 = -1.4426950408889634f * __builtin_amdgcn_rsqf(ms);
                float h[8];
#pragma unroll
                for (int n = 0; n < 2; ++n)
#pragma unroll
                    for (int e = 0; e < 4; ++e) { const float g = acc[ai][0][m][n][e], uu = acc[ai][1][m][n][e]; const float ex = __builtin_amdgcn_exp2f(g * c2); h[4 * n + e] = (g * uu) * __builtin_amdgcn_rcpf(__builtin_fmaf(ex, ms, ms)); }
                u32x4 w; w.x = cvt_pk_bf16(h[0], h[1]); w.y = cvt_pk_bf16(h[2], h[3]); w.z = cvt_pk_bf16(h[4], h[5]); w.w = cvt_pk_bf16(h[6], h[7]);
                *(u32x4*)(H + (size_t)row * ldh + col0) = w; }
    }
};
struct EpiResid {
    static constexpr bool PERM = true, AFTER_DRAIN = false;
    bf16_t* Xb; rs_t* rsn; float alpha;
    __device__ __forceinline__ void operator()(const f32x4 (&acc)[2][2][4][2], const Unit& u, int wr, int wc, int fr, int fq) const {
        const int row0 = u.pm * BM + wr * 64 + fr, col0 = u.pn * BM + wc * 32 + 8 * fq;
#pragma unroll
        for (int ai = 0; ai < 2; ++ai)
#pragma unroll
            for (int m = 0; m < 4; ++m) { const int row = row0 + ai * HALF + m * 16; float ss = 0.f;
#pragma unroll
                for (int bj = 0; bj < 2; ++bj) { const size_t off = (size_t)row * 2048 + col0 + bj * HALF; const u32x4 xo = *(const u32x4*)(Xb + off);
                    const f32x4 a0 = acc[ai][bj][m][0], a1 = acc[ai][bj][m][1];
                    u32x4 w; w.x = cvt_pk_bf16(bf_lo(xo.x) + a0[0] * alpha, bf_hi(xo.x) + a0[1] * alpha); w.y = cvt_pk_bf16(bf_lo(xo.y) + a0[2] * alpha, bf_hi(xo.y) + a0[3] * alpha);
                    w.z = cvt_pk_bf16(bf_lo(xo.z) + a1[0] * alpha, bf_hi(xo.z) + a1[1] * alpha); w.w = cvt_pk_bf16(bf_lo(xo.w) + a1[2] * alpha, bf_hi(xo.w) + a1[3] * alpha);
                    *(u32x4*)(Xb + off) = w;
                    const float v0 = bf_lo(w.x), v1 = bf_hi(w.x), v2 = bf_lo(w.y), v3 = bf_hi(w.y), v4 = bf_lo(w.z), v5 = bf_hi(w.z), v6 = bf_lo(w.w), v7 = bf_hi(w.w);
                    ss += ((v0 * v0 + v1 * v1) + (v2 * v2 + v3 * v3)) + ((v4 * v4 + v5 * v5) + (v6 * v6 + v7 * v7)); }
                ss += __shfl_xor(ss, 16); ss += __shfl_xor(ss, 32);
                if (fq == 0) rs_add(rsn + row, ss); }
    }
};
struct EpiGlu {
    static constexpr bool PERM = true, AFTER_DRAIN = false;
    bf16_t* Xb; rs_t* rsn;
    __device__ __forceinline__ void operator()(const f32x4 (&acc)[2][2][4][2], const Unit& u, int wr, int wc, int fr, int fq) const {
        const int row0 = u.pm * BM + wr * 64 + fr, col0 = u.pn * HALF + wc * 32 + 8 * fq;
#pragma unroll
        for (int ai = 0; ai < 2; ++ai)
#pragma unroll
            for (int m = 0; m < 4; ++m) { const int row = row0 + ai * HALF + m * 16; const size_t off = (size_t)row * 2048 + col0; const u32x4 xo = *(const u32x4*)(Xb + off);
                float v[8] = {bf_lo(xo.x), bf_hi(xo.x), bf_lo(xo.y), bf_hi(xo.y), bf_lo(xo.z), bf_hi(xo.z), bf_lo(xo.w), bf_hi(xo.w)};
#pragma unroll
                for (int n = 0; n < 2; ++n)
#pragma unroll
                    for (int e = 0; e < 4; ++e) v[4 * n + e] += acc[ai][0][m][n][e] * sigmoidf_fast(acc[ai][1][m][n][e]);
                u32x4 w; w.x = cvt_pk_bf16(v[0], v[1]); w.y = cvt_pk_bf16(v[2], v[3]); w.z = cvt_pk_bf16(v[4], v[5]); w.w = cvt_pk_bf16(v[6], v[7]); *(u32x4*)(Xb + off) = w;
                const float v0 = bf_lo(w.x), v1 = bf_hi(w.x), v2 = bf_lo(w.y), v3 = bf_hi(w.y), v4 = bf_lo(w.z), v5 = bf_hi(w.z), v6 = bf_lo(w.w), v7 = bf_hi(w.w);
                float ss = ((v0 * v0 + v1 * v1) + (v2 * v2 + v3 * v3)) + ((v4 * v4 + v5 * v5) + (v6 * v6 + v7 * v7));
                ss += __shfl_xor(ss, 16); ss += __shfl_xor(ss, 32);
                if (fq == 0) rs_add(rsn + row, ss); }
    }
};
struct EpiPartial {
    static constexpr bool PERM = true, AFTER_DRAIN = false;
    bf16_t* P;
    __device__ __forceinline__ void operator()(const f32x4 (&acc)[2][2][4][2], const Unit& u, int wr, int wc, int fr, int fq) const {
        bf16_t* base = P + (size_t)u.aux * (BM * BM) + (size_t)(wr * 64 + fr) * BM + wc * 32 + 8 * fq;
#pragma unroll
        for (int ai = 0; ai < 2; ++ai)
#pragma unroll
            for (int m = 0; m < 4; ++m) { bf16_t* rowp = base + (size_t)(ai * HALF + m * 16) * BM;
#pragma unroll
                for (int bj = 0; bj < 2; ++bj) { const f32x4 v0 = acc[ai][bj][m][0], v1 = acc[ai][bj][m][1];
                    u32x4 w; w.x = cvt_pk_bf16(v0[0], v0[1]); w.y = cvt_pk_bf16(v0[2], v0[3]); w.z = cvt_pk_bf16(v1[0], v1[1]); w.w = cvt_pk_bf16(v1[2], v1[3]); *(u32x4*)(rowp + bj * HALF) = w; } }
    }
};
struct EpiZ {
    static constexpr bool PERM = true, AFTER_DRAIN = false;
    bf16_t* Z; int ldz; const rs_t* rs; float inv_n; bf16_t* UGb; int Mrows;
    __device__ __forceinline__ void operator()(const f32x4 (&acc)[2][2][4][2], const Unit& u, int wr, int wc, int fr, int fq) const {
        const int row0 = u.pm * BM + wr * 64 + fr, col0 = u.pn * BM + wc * 32 + 8 * fq; const bool gate = u.pn >= 8;
#pragma unroll
        for (int ai = 0; ai < 2; ++ai)
#pragma unroll
            for (int m = 0; m < 4; ++m) { const int row = row0 + ai * HALF + m * 16; const float rstd = rstd_of(rs_get(rs[row]), inv_n); bf16_t* rowp = Z + (size_t)row * ldz + col0;
#pragma unroll
                for (int bj = 0; bj < 2; ++bj) { const f32x4 v0 = acc[ai][bj][m][0] * rstd, v1 = acc[ai][bj][m][1] * rstd;
                    u32x4 w; w.x = cvt_pk_bf16(v0[0], v0[1]); w.y = cvt_pk_bf16(v0[2], v0[3]); w.z = cvt_pk_bf16(v1[0], v1[1]); w.w = cvt_pk_bf16(v1[2], v1[3]);
                    if (gate) { const int cb = (u.pn - 8) * 16 + bj * 8 + wc * 2 + (fq >> 1); *(u32x4*)(UGb + ((size_t)cb * Mrows + row) * 16 + 8 * (fq & 1)) = w; }
                    else *(u32x4*)(rowp + bj * HALF) = w; } }
    }
};
struct EpiGate {
    static constexpr bool PERM = true, AFTER_DRAIN = false;
    const bf16_t* cvb; const float* ba; const float* bx; const float* ls; unsigned* GAB; int Mrows;
    __device__ __forceinline__ void operator()(const f32x4 (&acc)[2][2][4][2], const Unit& u, int wr, int wc, int fr, int fq) const {
        const int row0 = u.pm * BM + wr * 64 + fr, ch0 = u.pn * HALF + wc * 32 + 8 * fq;
        unsigned* gbase = GAB + ((size_t)(u.pn * 8 + wc * 2 + (fq >> 1)) * Mrows) * 16 + 8 * (fq & 1);
#pragma unroll
        for (int n = 0; n < 2; ++n) { const f32x4 bav = *(const f32x4*)(ba + ch0 + n * 4) * -1.4426950408889634f, bxv = *(const f32x4*)(bx + ch0 + n * 4) * -1.4426950408889634f, lsv = *(const f32x4*)(ls + ch0 + n * 4) * 8.0f;
#pragma unroll
            for (int ai = 0; ai < 2; ++ai)
#pragma unroll
                for (int m = 0; m < 4; ++m) { const int row = row0 + ai * HALF + m * 16; const bool first = (row < 8192) && ((row & 2047) == 0);
                    const u32x2 cw = *(const u32x2*)(cvb + (size_t)row * 1024 + ch0 + n * 4); const float cv[4] = {bf_lo(cw.x), bf_hi(cw.x), bf_lo(cw.y), bf_hi(cw.y)}; u32x4 w;
#pragma unroll
                    for (int e = 0; e < 4; ++e) {
                        const float r = __builtin_amdgcn_rcpf(1.0f + __builtin_amdgcn_exp2f(__builtin_fmaf(acc[ai][0][m][n][e], -1.4426950408889634f, bav[e])));
                        const float ig = __builtin_amdgcn_rcpf(1.0f + __builtin_amdgcn_exp2f(__builtin_fmaf(acc[ai][1][m][n][e], -1.4426950408889634f, bxv[e])));
                        float la = r * lsv[e]; const float x2 = la + la, a2 = __builtin_amdgcn_exp2f(x2 * 1.4426950408889634f);
                        const float om = (x2 > -0.1f) ? -x2 * (1.0f + x2 * (0.5f + x2 * (0.16666667f + x2 * 0.041666668f))) : 1.0f - a2;
                        float mult = __builtin_amdgcn_sqrtf(om);
                        if (first) { la = -30.0f; mult = 1.f; }
                        w[e] = cvt_pk_bf16(la, mult * ig * cv[e]); }
                    *(u32x4*)(gbase + (size_t)row * 16 + n * 4) = w;
                    asm volatile("" ::: "memory"); } }
    }
};
struct EpiPool {
    static constexpr bool PERM = true, AFTER_DRAIN = false;
    bf16_t* Y; int ldy; const float* scale;
    __device__ __forceinline__ void operator()(const f32x4 (&acc)[2][2][4][2], const Unit& u, int wr, int wc, int fr, int fq) const {
        const int row0 = u.pm * BM + wr * 64 + fr, col0 = u.pn * BM + wc * 32 + 8 * fq;
#pragma unroll
        for (int bj = 0; bj < 2; ++bj) { const f32x4 s0 = *(const f32x4*)(scale + col0 + bj * HALF), s1 = *(const f32x4*)(scale + col0 + bj * HALF + 4);
#pragma unroll
            for (int ai = 0; ai < 2; ++ai)
#pragma unroll
                for (int m = 0; m < 4; ++m) { bf16_t* rowp = Y + (size_t)(row0 + ai * HALF + m * 16) * ldy + col0 + bj * HALF;
                    const f32x4 v0 = acc[ai][bj][m][0] * s0, v1 = acc[ai][bj][m][1] * s1;
                    u32x4 w; w.x = cvt_pk_bf16(v0[0], v0[1]); w.y = cvt_pk_bf16(v0[2], v0[3]); w.z = cvt_pk_bf16(v1[0], v1[1]); w.w = cvt_pk_bf16(v1[2], v1[3]);
                    *(u32x4*)rowp = w; } }
    }
};

template <class Epi, class Sched, bool ALIGN_EPI = false, bool SP2 = false>
__device__ __forceinline__ void gemm_phase(PG8_LAS unsigned char* lds, const Gemm g, const Sched& S, const Epi& E) {
    int tid_ = threadIdx.x; asm volatile("" : "+v"(tid_));
    const int tid = tid_, wid = __builtin_amdgcn_readfirstlane(tid >> 6), lane = tid & 63, wr = wid >> 2, wc = wid & 3, fr = lane & 15, fq = lane >> 4;
    const int K = g.K;
    unsigned voffA[2], voffB[2];
#pragma unroll
    for (int i = 0; i < 2; ++i) { int R, C; stage_rc(tid * 16 + i * 8192, R, C); const int Rb = Epi::PERM ? ((R & ~31) + perm32(R & 31)) : R;
        voffA[i] = (unsigned)(R * g.lda + C) * 2u; voffB[i] = (unsigned)(Rb * K + C) * 2u; }
    const size_t kstep = (size_t)(BK * 2);
    const size_t hA = (size_t)HALF * g.lda * 2, hB = (size_t)HALF * K * 2;
    const size_t tA = 2 * hA, tB = 2 * hB;
    const unsigned ldsw = (unsigned)wid * 1024u;
    const int aoff = lds_byte(wr * 64 + fr, fq * 8), boff = lds_byte(wc * 32 + fr, fq * 8);
#define PG8_SA(b, h) (((b) * 2 + (h)) * HTB)
#define PG8_SB(b, h) ((4 + (b) * 2 + (h)) * HTB)
#define PG8_STAGE(bufoff, gbase, voff) do { _Pragma("unroll") for (int _i = 0; _i < 2; ++_i) \
        __builtin_amdgcn_global_load_lds((const unsigned*)((const char*)(gbase) + (voff)[_i]), (PG8_LAS unsigned*)(lds + (bufoff) + ldsw + _i * 8192), 16, 0, 0); } while (0)
#define PG8_LDA(dst, b, h) do { _Pragma("unroll") for (int m = 0; m < 4; ++m) _Pragma("unroll") for (int k = 0; k < 2; ++k) dst[m][k] = *(const PG8_LAS bf16x8*)(lds + PG8_SA(b, h) + aoff + m * 2048 + k * 1024); } while (0)
#define PG8_LDB(dst, b, h) do { _Pragma("unroll") for (int n = 0; n < 2; ++n) _Pragma("unroll") for (int k = 0; k < 2; ++k) dst[n][k] = *(const PG8_LAS bf16x8*)(lds + PG8_SB(b, h) + boff + n * 2048 + k * 1024); } while (0)
#define PG8_MMA(ai, bj, At, Bt) do { __builtin_amdgcn_s_setprio(1); _Pragma("unroll") for (int m = 0; m < 4; ++m) _Pragma("unroll") for (int n = 0; n < 2; ++n) _Pragma("unroll") for (int k = 0; k < 2; ++k) \
        acc[ai][bj][m][n] = __builtin_amdgcn_mfma_f32_16x16x32_bf16(Bt[n][k], At[m][k], acc[ai][bj][m][n], 0, 0, 0); __builtin_amdgcn_s_setprio(0); } while (0)
#define PG8_WAIT_V(n) asm volatile("s_waitcnt vmcnt(" #n ")" ::: "memory")
#define PG8_WAIT_L(n) asm volatile("s_waitcnt lgkmcnt(" #n ")" ::: "memory")
#define PG8_BAR __builtin_amdgcn_s_barrier()
#define PG8_SCHED __builtin_amdgcn_sched_barrier(0)
    Unit cur, nxt; int ui = 0;
    if (!S.next(0, cur)) return;
    f32x4 acc[2][2][4][2];
#pragma unroll
    for (int a = 0; a < 2; ++a)
#pragma unroll
        for (int b = 0; b < 2; ++b)
#pragma unroll
            for (int m = 0; m < 4; ++m)
#pragma unroll
                for (int n = 0; n < 2; ++n) acc[a][b][m][n] = (f32x4){0.f, 0.f, 0.f, 0.f};
    bf16x8 At[4][2], B0[2][2], B1[2][2];
    const char* cA = (const char*)g.A + (size_t)cur.pm * tA + (size_t)cur.ka * 2; const char* cB = (const char*)g.Bt + (size_t)cur.pn * tB + (size_t)cur.kb * 2; int nt = cur.nt;
    S.a_ready(cur, 0);
    if constexpr (SP2) {
        PG8_STAGE(PG8_SB(0, 0), cB, voffB); PG8_STAGE(PG8_SB(0, 1), cB + hB, voffB); PG8_STAGE(PG8_SA(0, 0), cA, voffA); PG8_STAGE(PG8_SA(0, 1), cA + hA, voffA);
        if (wr == 1) PG8_BAR;
        PG8_WAIT_V(2); PG8_BAR;
        PG8_STAGE(PG8_SB(1, 0), cB + kstep, voffB); PG8_STAGE(PG8_SA(1, 0), cA + kstep, voffA); PG8_STAGE(PG8_SB(1, 1), cB + hB + kstep, voffB);
        PG8_WAIT_V(6); PG8_BAR;
    } else {
        PG8_STAGE(PG8_SB(0, 0), cB, voffB); PG8_STAGE(PG8_SA(0, 0), cA, voffA); PG8_STAGE(PG8_SB(0, 1), cB + hB, voffB); PG8_STAGE(PG8_SA(0, 1), cA + hA, voffA);
        if (wr == 1) PG8_BAR;
        PG8_WAIT_V(4); PG8_BAR;
        PG8_STAGE(PG8_SB(1, 0), cB + kstep, voffB); PG8_STAGE(PG8_SA(1, 0), cA + kstep, voffA); PG8_STAGE(PG8_SB(1, 1), cB + hB + kstep, voffB);
        PG8_WAIT_V(6); PG8_BAR;
    }
    for (;;) {
        const bool has_next = S.next(ui + 1, nxt);
        const char* nA = has_next ? (const char*)g.A + (size_t)nxt.pm * tA + (size_t)nxt.ka * 2 : cA; const char* nB = has_next ? (const char*)g.Bt + (size_t)nxt.pn * tB + (size_t)nxt.kb * 2 : cB;
#pragma nounroll
        for (int t = 0; t < nt; t += 2) {
            const bool last = (t == nt - 2);
            const char* a1 = cA + (size_t)(t + 1) * kstep;
            const char* a2 = last ? nA : cA + (size_t)(t + 2) * kstep; const char* b2 = last ? nB : cB + (size_t)(t + 2) * kstep;
            const char* a3 = a2 + kstep; const char* b3 = b2 + kstep;
            if (last && has_next) S.a_ready(nxt, wid);
            if constexpr (SP2) {
            PG8_LDB(B0, 0, 0); PG8_LDB(B1, 0, 1); PG8_SCHED; PG8_LDA(At, 0, 0); PG8_STAGE(PG8_SA(1, 1), a1 + hA, voffA);
            PG8_WAIT_V(8); PG8_WAIT_L(0); PG8_BAR; PG8_MMA(0, 0, At, B0); PG8_MMA(0, 1, At, B1); PG8_BAR; PG8_SCHED;
            PG8_LDA(At, 0, 1); PG8_STAGE(PG8_SB(0, 0), b2, voffB); PG8_STAGE(PG8_SB(0, 1), b2 + hB, voffB); PG8_STAGE(PG8_SA(0, 0), a2, voffA);
            PG8_WAIT_V(8); PG8_WAIT_L(0); PG8_BAR; PG8_MMA(1, 0, At, B0); PG8_MMA(1, 1, At, B1); PG8_BAR; PG8_SCHED;
            PG8_LDB(B0, 1, 0); PG8_LDB(B1, 1, 1); PG8_SCHED; PG8_LDA(At, 1, 0); PG8_STAGE(PG8_SA(0, 1), a2 + hA, voffA);
            PG8_WAIT_V(8); PG8_WAIT_L(0); PG8_BAR; PG8_MMA(0, 0, At, B0); PG8_MMA(0, 1, At, B1); PG8_BAR; PG8_SCHED;
            PG8_LDA(At, 1, 1); PG8_STAGE(PG8_SB(1, 0), b3, voffB); PG8_STAGE(PG8_SB(1, 1), b3 + hB, voffB); PG8_STAGE(PG8_SA(1, 0), a3, voffA);
            PG8_WAIT_V(8); PG8_WAIT_L(0); PG8_BAR; PG8_MMA(1, 0, At, B0); PG8_MMA(1, 1, At, B1); PG8_BAR; PG8_SCHED;
            } else {
            PG8_LDB(B0, 0, 0); PG8_SCHED; PG8_LDA(At, 0, 0); PG8_STAGE(PG8_SA(1, 1), a1 + hA, voffA);
            PG8_WAIT_L(8); PG8_BAR; PG8_WAIT_L(0); PG8_MMA(0, 0, At, B0); PG8_BAR; PG8_SCHED;
            PG8_LDB(B1, 0, 1); PG8_STAGE(PG8_SB(0, 0), b2, voffB);
            PG8_BAR; PG8_WAIT_L(0); PG8_MMA(0, 1, At, B1); PG8_BAR;
            PG8_LDA(At, 0, 1); PG8_STAGE(PG8_SA(0, 0), a2, voffA);
            PG8_BAR; PG8_WAIT_L(0); PG8_MMA(1, 0, At, B0); PG8_BAR; PG8_SCHED;
            PG8_STAGE(PG8_SB(0, 1), b2 + hB, voffB);
            PG8_WAIT_V(6); PG8_BAR; PG8_MMA(1, 1, At, B1); PG8_BAR;
            PG8_LDB(B0, 1, 0); PG8_SCHED; PG8_LDA(At, 1, 0); PG8_STAGE(PG8_SA(0, 1), a2 + hA, voffA);
            PG8_WAIT_L(8); PG8_BAR; PG8_WAIT_L(0); PG8_MMA(0, 0, At, B0); PG8_BAR; PG8_SCHED;
            PG8_LDB(B1, 1, 1); PG8_STAGE(PG8_SB(1, 0), b3, voffB);
            PG8_BAR; PG8_WAIT_L(0); PG8_MMA(0, 1, At, B1); PG8_BAR;
            PG8_LDA(At, 1, 1); PG8_STAGE(PG8_SA(1, 0), a3, voffA);
            PG8_BAR; PG8_WAIT_L(0); PG8_MMA(1, 0, At, B0); PG8_BAR; PG8_SCHED;
            PG8_STAGE(PG8_SB(1, 1), b3 + hB, voffB);
            PG8_WAIT_V(6); PG8_BAR; PG8_MMA(1, 1, At, B1); PG8_BAR;
            }
        }
        if constexpr (ALIGN_EPI) { if (wr == 0) PG8_BAR; }
        if constexpr (!Epi::AFTER_DRAIN) { E(acc, cur, wr, wc, fr, fq); S.done(cur); }
        if (!has_next) break;
#pragma unroll
        for (int a = 0; a < 2; ++a)
#pragma unroll
            for (int b = 0; b < 2; ++b)
#pragma unroll
                for (int m = 0; m < 4; ++m)
#pragma unroll
                    for (int n = 0; n < 2; ++n) acc[a][b][m][n] = (f32x4){0.f, 0.f, 0.f, 0.f};
        cur = nxt; cA = nA; cB = nB; nt = cur.nt; ++ui;
        if constexpr (ALIGN_EPI) { if (wr == 1) PG8_BAR; }
    }
    PG8_WAIT_V(0);
    if constexpr (!ALIGN_EPI) { if (wr == 0) PG8_BAR; }
    PG8_BAR;
    if constexpr (Epi::AFTER_DRAIN) { E.fused(acc, cur, wr, wc, fr, fq, lds, wid, lane); S.done(cur); }
#undef PG8_SA
#undef PG8_SB
#undef PG8_STAGE
#undef PG8_LDA
#undef PG8_LDB
#undef PG8_MMA
#undef PG8_WAIT_V
#undef PG8_WAIT_L
#undef PG8_BAR
#undef PG8_SCHED
}
}

constexpr int D = 2048, NBP = 4, SEQ = 2048, NBS = 128, DSQ = 8, MP = NBP * SEQ, MS = NBS * DSQ, M = MP + MS;
constexpr int DFF = 5504, NFF = 2 * DFF, DPOOL = 1024, DRNN = 1024, DINE = 3072, POOLBUF = 15, NGRP = 128, NST = 64;
constexpr int NWAVES = 8, NTHR = 512;
constexpr float INV_D = 1.0f / 2048.0f;

constexpr size_t MiB = 1u << 20;
constexpr size_t WS_CTL = 0, CTL_ZERO_BYTES = 2 * MiB;
constexpr int CW_TMO = 0, CW_BAR = 4096, CW_FLAG = 8192;
constexpr size_t WS_RS = 64 * 1024;
constexpr int NRS = 14;
static_assert(WS_RS + (size_t)NRS * M * 8 <= CTL_ZERO_BYTES, "RS inside the memset region");
constexpr size_t SZ_FIN = (size_t)NFF * D * 2, SZ_FOUT = (size_t)D * DFF * 2, SZ_EIN = (size_t)DINE * D * 2, SZ_EOUT = (size_t)D * D * 2, SZ_POOL = (size_t)1024 * 256 * 2, SZ_GATE = (size_t)2048 * 256 * 2, SZ_GLU = (size_t)4096 * D * 2;
constexpr size_t WS_FIN = 2 * MiB, WS_FOUT = WS_FIN + 8 * SZ_FIN, WS_EIN = WS_FOUT + 8 * SZ_FOUT, WS_EOUT = WS_EIN + 2 * SZ_EIN, WS_POOL = WS_EOUT + 2 * SZ_EOUT, WS_GATE = WS_POOL + 2 * SZ_POOL, WS_GLU = WS_GATE + 2 * SZ_GATE;
constexpr size_t WS_AB = WS_GLU + 2 * SZ_GLU;
constexpr size_t WS_BB = WS_AB + (size_t)2 * 128 * 64 * 2 * 4;
constexpr size_t WS_LS = WS_BB + (size_t)2 * 128 * 64 * 32 * 4;
constexpr size_t WS_W1 = (WS_LS + 2 * 1024 * 4 + 255) / 256 * 256;
constexpr size_t WS_XB = WS_W1 + (size_t)2 * 128 * 128 * 256 * 2;
constexpr size_t WS_ACT = WS_XB + (size_t)M * D * 2;
constexpr size_t WS_H = WS_ACT;
constexpr size_t WS_Z = WS_ACT;
constexpr size_t WS_DP = WS_Z + (size_t)M * DINE * 4;
constexpr size_t WS_CV = WS_DP + (size_t)M * 1024 * 2;
constexpr size_t WS_CVF = WS_CV + (size_t)M * 1024 * 2;
constexpr size_t WS_GA = WS_CVF + (size_t)M * 1024 * 4;
constexpr size_t WS_GB = WS_GA + (size_t)M * 1024 * 4;
constexpr size_t WS_Y2 = WS_GB + (size_t)M * 1024 * 4;
constexpr size_t WS_UGB = WS_Y2 + (size_t)M * D * 2;
constexpr size_t WS_PART = WS_DP;
constexpr size_t WS_END = WS_UGB + (size_t)M * 1024 * 4;
static_assert(WS_H + (size_t)M * DFF * 2 <= WS_DP, "H overlays Z only");
static_assert(WS_PART + (size_t)256 * 65536 * 2 <= WS_END, "partial slabs fit");

constexpr size_t O_YP = 0, O_YS = O_YP + (size_t)MP * D, O_POOLP = O_YS + (size_t)MS * D, O_POOLS = O_POOLP + (size_t)2 * NBP * 15 * 1024, O_CONVP = O_POOLS + (size_t)2 * NBS * 15 * 1024,
                 O_CONVS = O_CONVP + (size_t)2 * NBP * 3 * 1024, O_HP = O_CONVS + (size_t)2 * NBS * 3 * 1024, O_HS = O_HP + (size_t)2 * NBP * 1024, O_REP = O_HS + (size_t)2 * NBS * 1024,
                 O_RES = O_REP + (size_t)2 * NBP * 128 * 64, O_IMP = O_RES + (size_t)2 * NBS * 128 * 64, O_IMS = O_IMP + (size_t)2 * NBP * 128 * 64, O_END = O_IMS + (size_t)2 * NBS * 128 * 64;

constexpr int RING_OFF = 0, RING_BYTES = 131072;
constexpr int LDSCTL_OFF = RING_BYTES, MISC_OFF = LDSCTL_OFF + 320;
constexpr int LDS_BYTES = 147456;
static_assert(MISC_OFF + 128 <= LDS_BYTES, "LDS map");

#define GAS __attribute__((address_space(1)))
#define LAS __attribute__((address_space(3)))
typedef unsigned short bf16;
typedef unsigned v4u __attribute__((ext_vector_type(4)));
typedef unsigned v2u __attribute__((ext_vector_type(2)));
typedef float f32x4 __attribute__((ext_vector_type(4)));
typedef GAS unsigned gu32;
#define RLX_AGENT __ATOMIC_RELAXED, __HIP_MEMORY_SCOPE_AGENT
#define LDS_WAIT() asm volatile("s_waitcnt lgkmcnt(0)" ::: "memory")
#define VM_WAIT() asm volatile("s_waitcnt vmcnt(0)" ::: "memory")
__device__ __forceinline__ unsigned f2bf(float f) { unsigned u = __builtin_bit_cast(unsigned, f); return (u + 0x7fffu + ((u >> 16) & 1u)) >> 16; }
typedef __bf16 bf16x2v __attribute__((ext_vector_type(2)));
typedef float f32x2c __attribute__((ext_vector_type(2)));
__device__ __forceinline__ unsigned pk2(float lo, float hi) { const bf16x2v b = __builtin_convertvector((f32x2c){lo, hi}, bf16x2v); return __builtin_bit_cast(unsigned, b); }
__device__ __forceinline__ float bf_lo(unsigned u) { return __builtin_bit_cast(float, u << 16); }
__device__ __forceinline__ float bf_hi(unsigned u) { return __builtin_bit_cast(float, u & 0xffff0000u); }
__device__ __forceinline__ float wave_sum(float v) {
#pragma unroll
    for (int o = 1; o < 64; o <<= 1) v += __shfl_xor(v, o);
    return v;
}
__device__ __forceinline__ float gelu_tanh(float v) { const float z = 1.5957691216057308f * (v + 0.044715f * v * v * v); return v * __builtin_amdgcn_rcpf(1.0f + __expf(-z)); }

#define XB_TMO      128
#define XB_XCNT(j)  (256  + 64 * (j))
#define XB_XSUB(j)  (1280 + 64 * (j))
#define XB_XGEN(j)  (2304 + 64 * (j))
#define XB_TOP      3328
#define XB_TOPGEN   3392
#define XCD_BAR_WORDS 3456
#define XB_SPIN_CAP (1u << 18)

__device__ __forceinline__ unsigned xb_ld(unsigned* p)              { return __hip_atomic_load(p, __ATOMIC_RELAXED, __HIP_MEMORY_SCOPE_AGENT); }
__device__ __forceinline__ unsigned xb_add(unsigned* p, unsigned v) { return __hip_atomic_fetch_add(p, v, __ATOMIC_RELAXED, __HIP_MEMORY_SCOPE_AGENT); }
__device__ __forceinline__ unsigned xb_xcc_id() { return (unsigned)__builtin_amdgcn_s_getreg((3 << 11) | 20) & 0xFu; }
#define XB_SPIN(cond, bar) do { unsigned _sp = 0; while (cond) { __builtin_amdgcn_s_sleep(1); \
    if ((++_sp & 255u) == 0u) { if (xb_ld(&(bar)[XB_TMO])) break; if (_sp > XB_SPIN_CAP) { atomicAdd(&(bar)[XB_TMO], 1u); break; } } } } while (0)

struct XcdBarrier {
    unsigned* bar; unsigned x;
    volatile LAS unsigned* st;
};

__device__ __forceinline__ XcdBarrier xcd_barrier_post(unsigned* bar, volatile LAS unsigned* st) {
    XcdBarrier b; b.bar = bar; b.x = xb_xcc_id(); b.st = st;
    if (threadIdx.x == 0) (void)xb_add(&bar[XB_XCNT(b.x)], 1u);
    return b;
}
__device__ __forceinline__ void xcd_barrier_complete(unsigned* bar, unsigned x, unsigned& nloc, unsigned& nx) {
    const unsigned G = gridDim.x * gridDim.y * gridDim.z;
    unsigned sum, cnt, mine, sp = 0u;
    for (;;) {
        sum = 0u; cnt = 0u; mine = 0u;
#pragma unroll
        for (unsigned j = 0; j < 16; ++j) { const unsigned c = xb_ld(&bar[XB_XCNT(j)]); sum += c; cnt += (c > 0u) ? 1u : 0u; mine = (j == x) ? c : mine; }
        if (sum == G) break;
        __builtin_amdgcn_s_sleep(1);
        if ((++sp & 255u) == 0u) { if (xb_ld(&bar[XB_TMO])) break; if (sp > XB_SPIN_CAP) { atomicAdd(&bar[XB_TMO], 1u); break; } }
    }
    nloc = mine > 0u ? mine : 1u; nx = cnt > 0u ? cnt : 1u;
}

__device__ __forceinline__ void xcd_barrier(const XcdBarrier& b) {
    asm volatile("s_waitcnt vmcnt(0)" ::: "memory");
    __syncthreads();
    if (threadIdx.x == 0) {
        unsigned* bar = b.bar;
        __builtin_amdgcn_s_waitcnt(0);
        unsigned nloc = b.st[0], nx = b.st[1];
        if (nloc == 0u) { xcd_barrier_complete(bar, b.x, nloc, nx); b.st[0] = nloc; b.st[1] = nx; }
        const unsigned old = xb_add(&bar[XB_XSUB(b.x)], 1u);
        const unsigned gen = old / nloc;
        if (old + 1u == (gen + 1u) * nloc) {
            __builtin_amdgcn_fence(__ATOMIC_RELEASE, "agent");
            asm volatile("s_waitcnt vmcnt(0)" ::: "memory");
            const unsigned og = xb_add(&bar[XB_TOP], 1u);
            const unsigned tg = og / nx;
            if (og + 1u == (tg + 1u) * nx) xb_add(&bar[XB_TOPGEN], 1u);
            else XB_SPIN(xb_ld(&bar[XB_TOPGEN]) == tg, bar);
            __builtin_amdgcn_fence(__ATOMIC_ACQUIRE, "agent");
            xb_add(&bar[XB_XGEN(b.x)], 1u);
            asm volatile("s_waitcnt vmcnt(0)" ::: "memory");
        } else {
            __builtin_amdgcn_fence(__ATOMIC_ACQUIRE, "agent");
            asm volatile("s_waitcnt vmcnt(0)" ::: "memory");
            XB_SPIN(xb_ld(&bar[XB_XGEN(b.x)]) == gen, bar);
            asm volatile("" ::: "memory");
        }
    }
    __syncthreads();
}
struct Args { const float* in[35]; float* out; unsigned char* ws; int lo, hi; };

struct CvtJob { const float* W; const float* ks; bf16* dst; int ldw, K, Nd, kind, HO, ldd; };
__device__ __forceinline__ void cvt_item(const CvtJob& j, int item, int lane, LAS unsigned* T) {
    const int nblk = j.Nd >> 6, kb = item / nblk, nb = item - kb * nblk, k0 = kb * 64, n0 = nb * 64;
    int sc0 = n0; if (j.kind == 1) sc0 = ((n0 >> 7) & 1) * j.HO + (n0 >> 8) * 128 + (n0 & 127);
    const float* src = j.W + (size_t)k0 * j.ldw + sc0 + lane;
    float v[64];
#pragma unroll
    for (int kk = 0; kk < 64; ++kk) v[kk] = __builtin_nontemporal_load(src + (size_t)kk * j.ldw);
    if (j.ks) {
#pragma unroll
        for (int kk = 0; kk < 64; ++kk) v[kk] *= j.ks[k0 + kk]; }
#pragma unroll
    for (int q = 0; q < 8; ++q) { v4u o; o.x = pk2(v[8 * q], v[8 * q + 1]); o.y = pk2(v[8 * q + 2], v[8 * q + 3]); o.z = pk2(v[8 * q + 4], v[8 * q + 5]); o.w = pk2(v[8 * q + 6], v[8 * q + 7]); *(LAS v4u*)(T + lane * 36 + 4 * q) = o; }
    LDS_WAIT(); asm volatile("" ::: "memory");
    const int c = lane & 7, r0 = lane >> 3;
#pragma unroll
    for (int i = 0; i < 8; ++i) { const int r = r0 + 8 * i; const v4u o = *(const LAS v4u*)(T + r * 36 + 4 * c); *(v4u*)(j.dst + (size_t)(n0 + r) * j.ldd + k0 + 8 * c) = o; }
    LDS_WAIT(); asm volatile("" ::: "memory");
}
constexpr int NJOBS = 62;
__device__ __forceinline__ CvtJob get_job(int jj, const Args& a) {
    CvtJob j; j.kind = 0; j.HO = 0; j.ks = nullptr; unsigned char* ws = a.ws;
    if (jj < 16) { const int l = jj >> 2, w = jj & 3, fi = 2 * l + (w >> 1);
        if ((w & 1) == 0) { j.W = a.in[w == 0 ? 8 : 12] + (size_t)l * D * NFF; j.ldw = NFF; j.K = D; j.Nd = NFF; j.kind = 1; j.HO = DFF; j.dst = (bf16*)(ws + WS_FIN + fi * SZ_FIN); j.ldd = D; j.ks = a.in[w == 0 ? 7 : 11] + l * D; }
        else { j.W = a.in[w == 1 ? 9 : 13] + (size_t)l * DFF * D; j.ldw = D; j.K = DFF; j.Nd = D; j.dst = (bf16*)(ws + WS_FOUT + fi * SZ_FOUT); j.ldd = DFF; } }
    else if (jj < 18) { const int e = jj - 16; j.W = a.in[14] + (size_t)e * D * DINE; j.ldw = DINE; j.K = D; j.Nd = DINE; j.dst = (bf16*)(ws + WS_EIN + e * SZ_EIN); j.ldd = D; j.ks = a.in[10] + (2 * e) * D; }
    else if (jj < 20) { const int e = jj - 18; j.W = a.in[24] + (size_t)e * D * D; j.ldw = D; j.K = D; j.Nd = D; j.dst = (bf16*)(ws + WS_EOUT + e * SZ_EOUT); j.ldd = D; }
    else if (jj < 22) { const int o = jj - 20; j.W = a.in[33] + (size_t)o * D * 4096; j.ldw = 4096; j.K = D; j.Nd = 4096; j.kind = 1; j.HO = 2048; j.dst = (bf16*)(ws + WS_GLU + o * SZ_GLU); j.ldd = D; }
    else if (jj < 30) { const int q = jj - 22, e = q >> 2, g = q & 3; j.W = a.in[15] + (size_t)(e * 4 + g) * 65536; j.ldw = 256; j.K = 256; j.Nd = 256; j.dst = (bf16*)(ws + WS_POOL + e * SZ_POOL) + (size_t)(g * 256) * 256; j.ldd = 256; }
    else { const int q = jj - 30, e = q >> 4, r = q & 15, isx = r >> 3, h = r & 7; j.W = a.in[isx ? 21 : 19] + (size_t)(e * 8 + h) * 16384; j.ldw = 128; j.K = 128; j.Nd = 128;
        j.dst = (bf16*)(ws + WS_GATE + e * SZ_GATE) + (size_t)(256 * h + 128 * isx) * 256 + (h & 1) * 128; j.ldd = 256; }
    return j;
}
__device__ const unsigned char CVT_JOBS[62] = { 0, 1, 22, 23, 24, 25, 30, 31, 32, 33, 34, 35, 36, 37, 38, 39, 40, 41, 42, 43, 44, 45, 16, 18, 2, 20, 3, 4, 17, 19, 5, 6, 7, 8, 26, 27, 28, 29, 46, 47, 48, 49, 50, 51, 52, 53, 54, 55, 56, 57, 58, 59, 60, 61, 9, 10, 11, 12, 21, 13, 14, 15 };
__device__ const unsigned char CVT_STAGE_START[10] = { 0, 1, 26, 30, 32, 54, 56, 59, 61, 62 };
__device__ __forceinline__ void cvt_stage(const Args& a, int stage, int widx, int nw, int lane, LAS unsigned* T) {
    int off = 0;
    for (int q = CVT_STAGE_START[stage]; q < CVT_STAGE_START[stage + 1]; ++q) { const CvtJob j = get_job(CVT_JOBS[q], a); const int nitems = (j.K >> 6) * (j.Nd >> 6);
        int first = widx - off; if (first < 0) first += nw;
        for (int it = first; it < nitems; it += nw) cvt_item(j, it, lane, T);
        off = (off + nitems) % nw; }
}
__device__ __forceinline__ void p0_prologue(const Args& a, LAS unsigned char* lds) {
    int tid = threadIdx.x; asm volatile("" : "+v"(tid)); const int lane = tid & 63, wave = __builtin_amdgcn_readfirstlane(tid >> 6);
    const int G = gridDim.x, gw = blockIdx.x * NWAVES + wave, NGW = G * NWAVES; unsigned char* ws = a.ws;
    cvt_stage(a, 0, gw, NGW, lane, (LAS unsigned*)(lds + RING_OFF + wave * 9216));
    { const int gt = blockIdx.x * NTHR + tid, NT = G * NTHR;
      for (int i = gt; i < 2 * 8 * 256 * 16; i += NT) { const int ch = i & 15, r = (i >> 4) & 255, h = (i >> 12) & 7, e = i >> 15;
          *(v4u*)((bf16*)(ws + WS_GATE + e * SZ_GATE) + (size_t)(256 * h + r) * 256 + ((h & 1) ^ 1) * 128 + ch * 8) = (v4u){0u, 0u, 0u, 0u}; }
      for (int i = (tid < 64 ? (int)blockIdx.x * 64 + tid : 2 * 128 * 64); i < 2 * 128 * 64; i += G * 64) { const int og = i >> 6, p = i & 63;
          const float lr = fminf(a.in[25][i], -1e-4f), li = a.in[26][i], dt = expf(a.in[27][og]);
          const float mag = expf(lr * dt), abr = mag * cosf(li * dt), abi = mag * sinf(li * dt), den = lr * lr + li * li, nr = abr - 1.0f;
          const float fre = (nr * lr + abi * li) / den, fim = (abi * lr - nr * li) / den;
          float* AB = (float*)(ws + WS_AB) + (size_t)i * 2; AB[0] = abr; AB[1] = abi;
          float* BB = (float*)(ws + WS_BB) + (size_t)i * 32; const float* br = a.in[28] + (size_t)i * 16; const float* bi = a.in[29] + (size_t)i * 16;
          float bre[16], bim[16];
#pragma unroll
          for (int c = 0; c < 16; ++c) { bre[c] = fre * br[c] - fim * bi[c]; bim[c] = fre * bi[c] + fim * br[c]; BB[c] = bre[c]; BB[16 + c] = bim[c]; }
          bf16* W1t = (bf16*)(ws + WS_W1) + (size_t)og * 128 * 256; float pr = 1.f, pi = 0.f;
          const int ppr_ = 2 * p, ppi_ = 2 * p + 1;
          for (int n = 0; n < 16; ++n) { const int s = 15 - n; v4u wr0, wr1, wi0, wi1;
              wr0.x = pk2(pr * bre[0] - pi * bim[0], pr * bre[1] - pi * bim[1]); wr0.y = pk2(pr * bre[2] - pi * bim[2], pr * bre[3] - pi * bim[3]); wr0.z = pk2(pr * bre[4] - pi * bim[4], pr * bre[5] - pi * bim[5]); wr0.w = pk2(pr * bre[6] - pi * bim[6], pr * bre[7] - pi * bim[7]);
              wr1.x = pk2(pr * bre[8] - pi * bim[8], pr * bre[9] - pi * bim[9]); wr1.y = pk2(pr * bre[10] - pi * bim[10], pr * bre[11] - pi * bim[11]); wr1.z = pk2(pr * bre[12] - pi * bim[12], pr * bre[13] - pi * bim[13]); wr1.w = pk2(pr * bre[14] - pi * bim[14], pr * bre[15] - pi * bim[15]);
              wi0.x = pk2(pr * bim[0] + pi * bre[0], pr * bim[1] + pi * bre[1]); wi0.y = pk2(pr * bim[2] + pi * bre[2], pr * bim[3] + pi * bre[3]); wi0.z = pk2(pr * bim[4] + pi * bre[4], pr * bim[5] + pi * bre[5]); wi0.w = pk2(pr * bim[6] + pi * bre[6], pr * bim[7] + pi * bre[7]);
              wi1.x = pk2(pr * bim[8] + pi * bre[8], pr * bim[9] + pi * bre[9]); wi1.y = pk2(pr * bim[10] + pi * bre[10], pr * bim[11] + pi * bre[11]); wi1.z = pk2(pr * bim[12] + pi * bre[12], pr * bim[13] + pi * bre[13]); wi1.w = pk2(pr * bim[14] + pi * bre[14], pr * bim[15] + pi * bre[15]);
              { const size_t fr_ = ((size_t)((ppr_ >> 5) * 2 + ((ppr_ >> 4) & 1)) * 8 + (s >> 1)) * 64, fi_ = ((size_t)((ppi_ >> 5) * 2 + ((ppi_ >> 4) & 1)) * 8 + (s >> 1)) * 64; const int q0_ = 2 * (s & 1);
                *(v4u*)(W1t + (fr_ + q0_ * 16 + (ppr_ & 15)) * 8) = wr0; *(v4u*)(W1t + (fr_ + (q0_ + 1) * 16 + (ppr_ & 15)) * 8) = wr1;
                *(v4u*)(W1t + (fi_ + q0_ * 16 + (ppi_ & 15)) * 8) = wi0; *(v4u*)(W1t + (fi_ + (q0_ + 1) * 16 + (ppi_ & 15)) * 8) = wi1; }
              const float npr = pr * abr - pi * abi, npi = pr * abi + pi * abr; pr = npr; pi = npi; } }
      for (int i = gt; i < 2 * 1024; i += NT) ((float*)(ws + WS_LS))[i] = -log1pf(expf(-a.in[23][i])); }
    bf16* Xb = (bf16*)(ws + WS_XB); pg8::rs_t* rs0 = (pg8::rs_t*)(ws + WS_RS);
    for (int m = gw; m < M; m += NGW) { const float* src = (m < MP) ? a.in[0] + (size_t)m * D : a.in[1] + (size_t)(m - MP) * D;
        float s = 0.f;
#pragma unroll
        for (int q = 0; q < 8; ++q) { const f32x4 v = *((const f32x4*)src + lane + 64 * q);
            v2u w; w.x = pk2(v[0], v[1]); w.y = pk2(v[2], v[3]); *((v2u*)(Xb + (size_t)m * D) + lane + 64 * q) = w;
            const float v0 = bf_lo(w.x), v1 = bf_hi(w.x), v2 = bf_lo(w.y), v3 = bf_hi(w.y); s += (v0 * v0 + v1 * v1) + (v2 * v2 + v3 * v3); }
        s = wave_sum(s); if (lane == 0) rs0[m] = (pg8::rs_t)(s * 1048576.0f + 0.5f); }
}

__device__ __forceinline__ void row_decode(int row, bool& isP, int& b, int& t, int& base) {
    if (row < MP) { isP = true; b = row >> 11; t = row & 2047; base = b << 11; } else { isP = false; const int q = row - MP; b = q >> 3; t = q & 7; base = MP + (b << 3); } }
__device__ __forceinline__ f32x4 ep_fetch(const bf16* Zc, int base, int tt, const float* st, int nbuf) {
    if (tt >= 0) { const v2u w = *(const v2u*)(Zc + (size_t)(base + tt) * 2048); return (f32x4){bf_lo(w.x), bf_hi(w.x), bf_lo(w.y), bf_hi(w.y)}; }
    if (st) return *(const f32x4*)(st + (size_t)(nbuf + tt) * 1024);
    return (f32x4){0.f, 0.f, 0.f, 0.f};
}
__device__ __forceinline__ f32x4 ep_cvt(v2u w) { return (f32x4){bf_lo(w.x), bf_hi(w.x), bf_lo(w.y), bf_hi(w.y)}; }
template <int W, bool FIRST>
__device__ __forceinline__ void ep_pool_fast(const bf16* Zr, bf16* Dr, float* ost, int t0) {
    v2u raw[31 + W];
#pragma unroll
    for (int i = 0; i < 31 + W; ++i) raw[i] = (FIRST && i < W - 1) ? (v2u){0u, 0u} : *(const v2u*)(Zr + (ptrdiff_t)(i - (W - 1)) * 2048);
    f32x4 s = (f32x4){0.f, 0.f, 0.f, 0.f};
    if (!FIRST) {
#pragma unroll
        for (int i = 0; i < W - 1; ++i) s += ep_cvt(raw[i]); }
#pragma unroll
    for (int k = 0; k < 32; ++k) { const f32x4 un = ep_cvt(raw[W - 1 + k]); s += un; const float inv = (FIRST && k + 1 < W) ? 1.0f / (float)(k + 1) : 1.0f / (float)W; const f32x4 d = (FIRST && k + 1 < W) ? s / (float)(k + 1) - un : s * inv - un;
        v2u o; o.x = pk2(d[0], d[1]); o.y = pk2(d[2], d[3]); *(v2u*)(Dr + (size_t)k * 1024) = o;
        if (!FIRST) { if (t0 + k >= SEQ - 15) *(f32x4*)(ost + (size_t)(t0 + k - (SEQ - 15)) * 1024) = un; }
        if (!(FIRST && k < W - 1)) s -= ep_cvt(raw[k]); }
}
template <int W>
__device__ __forceinline__ void ep_pool_sample(const bf16* Zr, bf16* Dr, const float* st, float* ost) {
    f32x4 pv[W - 1]; v2u raw[8]; f32x4 keep[7];
#pragma unroll
    for (int i = 0; i < W - 1; ++i) pv[i] = *(const f32x4*)(st + (size_t)(15 - (W - 1) + i) * 1024);
#pragma unroll
    for (int i = 0; i < 8; ++i) raw[i] = *(const v2u*)(Zr + (size_t)i * 2048);
#pragma unroll
    for (int i = 0; i < 7; ++i) keep[i] = *(const f32x4*)(st + (size_t)(8 + i) * 1024);
    f32x4 s = (f32x4){0.f, 0.f, 0.f, 0.f};
#pragma unroll
    for (int i = 0; i < W - 1; ++i) s += pv[i];
#pragma unroll
    for (int k = 0; k < 8; ++k) { const f32x4 un = ep_cvt(raw[k]); s += un; const f32x4 d = s / (float)W - un;
        v2u o; o.x = pk2(d[0], d[1]); o.y = pk2(d[2], d[3]); *(v2u*)(Dr + (size_t)k * 1024) = o;
        *(f32x4*)(ost + (size_t)(7 + k) * 1024) = un; if (k < 7) *(f32x4*)(ost + (size_t)k * 1024) = keep[k];
        s -= (k < W - 1) ? pv[k < W - 1 ? k : 0] : ep_cvt(raw[k - (W - 1) < 0 ? 0 : k - (W - 1)]); }
}
__device__ __forceinline__ void even_prep(const Args& a, int e) {
    int tid = threadIdx.x; asm volatile("" : "+v"(tid));
    unsigned char* ws = a.ws; const bf16* Z = (const bf16*)(ws + WS_Z); bf16* Dp = (bf16*)(ws + WS_DP); bf16* Cv = (bf16*)(ws + WS_CV);
    const float* spool = a.in[2] + (size_t)e * NBS * 15 * 1024; const float* sconv = a.in[3] + (size_t)e * NBS * 3 * 1024;
    const float* cw = a.in[17] + (size_t)e * 4 * 1024; const float* cb = a.in[18] + (size_t)e * 1024;
    float* o_poolp = a.out + O_POOLP + (size_t)e * NBP * 15 * 1024; float* o_pools = a.out + O_POOLS + (size_t)e * NBS * 15 * 1024;
    float* o_convp = a.out + O_CONVP + (size_t)e * NBP * 3 * 1024; float* o_convs = a.out + O_CONVS + (size_t)e * NBS * 3 * 1024;
    const int NT = gridDim.x * NTHR; constexpr int RUN = 32, NPR = (MP / RUN) * 512, NSR = NBS * 512;
    for (int idx = blockIdx.x * NTHR + tid; idx < NPR + NSR; idx += NT) {
        const bool isP = idx < NPR; const int r = isP ? idx : idx - NPR, q = r & 511, ck = r >> 9;
        const int b = isP ? (ck >> 6) : ck, t0 = isP ? (ck & 63) * RUN : 0, nrun = isP ? RUN : DSQ, base = isP ? b * SEQ : MP + b * DSQ;
        if (q < 256) {
            const int c = q * 4, w = 2 << (c >> 8); const bf16* Zc = Z + c; const float* st = isP ? nullptr : spool + (size_t)b * 15 * 1024 + c;
            { const bf16* Zr = Zc + (size_t)(base + t0) * 2048; bf16* Dr = Dp + (size_t)(base + t0) * 1024 + c;
              if (isP) { float* ost = o_poolp + (size_t)b * 15 * 1024 + c;
                if (t0 != 0) { if (w == 2) ep_pool_fast<2, false>(Zr, Dr, ost, t0); else if (w == 4) ep_pool_fast<4, false>(Zr, Dr, ost, t0); else if (w == 8) ep_pool_fast<8, false>(Zr, Dr, ost, t0); else ep_pool_fast<16, false>(Zr, Dr, ost, t0); }
                else { if (w == 2) ep_pool_fast<2, true>(Zr, Dr, ost, t0); else if (w == 4) ep_pool_fast<4, true>(Zr, Dr, ost, t0); else if (w == 8) ep_pool_fast<8, true>(Zr, Dr, ost, t0); else ep_pool_fast<16, true>(Zr, Dr, ost, t0); } }
              else { float* ost = o_pools + (size_t)b * 15 * 1024 + c;
                if (w == 2) ep_pool_sample<2>(Zr, Dr, st, ost); else if (w == 4) ep_pool_sample<4>(Zr, Dr, st, ost); else if (w == 8) ep_pool_sample<8>(Zr, Dr, st, ost); else ep_pool_sample<16>(Zr, Dr, st, ost); }
              continue; }
            f32x4 s = (f32x4){0.f, 0.f, 0.f, 0.f};
            for (int j = 1; j < w; ++j) s += ep_fetch(Zc, base, t0 - j, st, 15);
            for (int tb = 0; tb < nrun; tb += 8) { f32x4 un[8], uo[8];
#pragma unroll
                for (int k = 0; k < 8; ++k) { un[k] = ep_fetch(Zc, base, t0 + tb + k, st, 15); uo[k] = ep_fetch(Zc, base, t0 + tb + k - w + 1, st, 15); }
#pragma unroll
                for (int k = 0; k < 8; ++k) { const int t = t0 + tb + k; s += un[k];
                    const float cnt = isP ? (float)((t + 1) < w ? (t + 1) : w) : (float)w; const f32x4 d = s / cnt - un[k];
                    v2u o; o.x = pk2(d[0], d[1]); o.y = pk2(d[2], d[3]); *(v2u*)(Dp + (size_t)(base + t) * 1024 + c) = o;
                    if (isP) { if (t >= SEQ - 15) *(f32x4*)(o_poolp + ((size_t)b * 15 + (t - (SEQ - 15))) * 1024 + c) = un[k]; }
                    else { *(f32x4*)(o_pools + ((size_t)b * 15 + 7 + t) * 1024 + c) = un[k];
                           if (t < 7) *(f32x4*)(o_pools + ((size_t)b * 15 + t) * 1024 + c) = *(const f32x4*)(st + (size_t)(8 + t) * 1024); }
                    s -= uo[k]; } }
        } else {
            const int c = (q - 256) * 4; const bf16* Zc = Z + 1024 + c; const float* st = isP ? nullptr : sconv + (size_t)b * 3 * 1024 + c;
            const f32x4 w0 = *(const f32x4*)(cw + c), w1 = *(const f32x4*)(cw + 1024 + c), w2 = *(const f32x4*)(cw + 2048 + c), w3 = *(const f32x4*)(cw + 3072 + c), bias = *(const f32x4*)(cb + c);
            if (isP) { const bf16* Zr = Zc + (size_t)(base + t0) * 2048; bf16* Cr = Cv + (size_t)(base + t0) * 1024 + c; v2u raw[35]; const bool first = t0 == 0;
#pragma unroll
                for (int i = 0; i < 35; ++i) raw[i] = (i < 3 && first) ? (v2u){0u, 0u} : *(const v2u*)(Zr + (ptrdiff_t)(i - 3) * 2048);
#pragma unroll
                for (int k = 0; k < 32; ++k) { const f32x4 un = ep_cvt(raw[k + 3]); const f32x4 acc = bias + ep_cvt(raw[k]) * w0 + ep_cvt(raw[k + 1]) * w1 + ep_cvt(raw[k + 2]) * w2 + un * w3;
                    v2u o; o.x = pk2(acc[0], acc[1]); o.y = pk2(acc[2], acc[3]); *(v2u*)(Cr + (size_t)k * 1024) = o;
                    if (t0 + k >= SEQ - 3) *(f32x4*)(o_convp + ((size_t)b * 3 + (t0 + k - (SEQ - 3))) * 1024 + c) = un; }
                continue; }
            else { const bf16* Zr = Zc + (size_t)base * 2048; bf16* Cr = Cv + (size_t)base * 1024 + c; v2u raw[8];
                f32x4 p3 = *(const f32x4*)(st), p2 = *(const f32x4*)(st + 1024), p1 = *(const f32x4*)(st + 2048);
#pragma unroll
                for (int i = 0; i < 8; ++i) raw[i] = *(const v2u*)(Zr + (size_t)i * 2048);
#pragma unroll
                for (int k = 0; k < 8; ++k) { const f32x4 un = ep_cvt(raw[k]); const f32x4 acc = bias + p3 * w0 + p2 * w1 + p1 * w2 + un * w3;
                    v2u o; o.x = pk2(acc[0], acc[1]); o.y = pk2(acc[2], acc[3]); *(v2u*)(Cr + (size_t)k * 1024) = o;
                    if (k >= DSQ - 3) *(f32x4*)(o_convs + ((size_t)b * 3 + (k - (DSQ - 3))) * 1024 + c) = un;
                    p3 = p2; p2 = p1; p1 = un; }
                continue; }
            f32x4 p3 = ep_fetch(Zc, base, t0 - 3, st, 3), p2 = ep_fetch(Zc, base, t0 - 2, st, 3), p1 = ep_fetch(Zc, base, t0 - 1, st, 3);
            for (int tb = 0; tb < nrun; tb += 8) { f32x4 un[8];
#pragma unroll
                for (int k = 0; k < 8; ++k) un[k] = ep_fetch(Zc, base, t0 + tb + k, st, 3);
#pragma unroll
                for (int k = 0; k < 8; ++k) { const int t = t0 + tb + k; const f32x4 acc = bias + p3 * w0 + p2 * w1 + p1 * w2 + un[k] * w3;
                    v2u o; o.x = pk2(acc[0], acc[1]); o.y = pk2(acc[2], acc[3]); *(v2u*)(Cv + (size_t)(base + t) * 1024 + c) = o;
                    if (isP) { if (t >= SEQ - 3) *(f32x4*)(o_convp + ((size_t)b * 3 + (t - (SEQ - 3))) * 1024 + c) = un[k]; }
                    else if (t >= DSQ - 3) *(f32x4*)(o_convs + ((size_t)b * 3 + (t - (DSQ - 3))) * 1024 + c) = un[k];
                    p3 = p2; p2 = p1; p1 = un[k]; } }
        }
    }
}

__device__ __forceinline__ void even_scan(const Args& a, int e, LAS unsigned char* lds) {
    int tid = threadIdx.x; asm volatile("" : "+v"(tid));
    unsigned char* ws = a.ws; const unsigned* GAB = (const unsigned*)(ws + WS_GA); const bf16* UG = (const bf16*)(ws + WS_UGB); bf16* Y2 = (bf16*)(ws + WS_Y2);
    float* o_hp = a.out + O_HP + (size_t)e * NBP * 1024; float* o_hs = a.out + O_HS + (size_t)e * NBS * 1024; const float* h0s = a.in[4] + (size_t)e * NBS * 1024;
    const int G = gridDim.x; LAS float* car = (LAS float*)(lds + RING_OFF);
    const int ck = tid >> 4, cl = tid & 15;
    for (int it = blockIdx.x; it < NBP * 64; it += G) { const int b = (it >> 6) & 3, cb = 8 * (it & 7) + ((it >> 3) & 7), r0 = b * SEQ + ck * 64;
        const size_t ob = ((size_t)cb * M + r0) * 16 + cl; const unsigned* pg = GAB + ob; const bf16* pu = UG + ob;
        float av[64], bv[64];
#pragma unroll
        for (int t = 0; t < 64; ++t) { const unsigned w = pg[t * 16]; av[t] = bf_lo(w); bv[t] = bf_hi(w); }
        bf16 ugn[16];
#pragma unroll
        for (int k = 0; k < 16; ++k) ugn[k] = pu[k * 16];
        float A = 1.f, h = 0.f;
#pragma unroll
        for (int t = 0; t < 64; ++t) { av[t] = __expf(av[t]); h = av[t] * h + bv[t]; A *= av[t]; }
        car[(ck * 2 + 0) * 16 + cl] = A; car[(ck * 2 + 1) * 16 + cl] = h;
        LDS_WAIT(); __syncthreads();
        float c = 0.f;
#pragma unroll 8
        for (int j = 0; j < 32; ++j) { const float ca = car[(j * 2 + 0) * 16 + cl], ch = car[(j * 2 + 1) * 16 + cl]; c = j < ck ? ca * c + ch : c; }
        h = c; bf16* py = Y2 + (size_t)r0 * D + 1024 + cb * 16 + cl;
#pragma unroll
        for (int tb = 0; tb < 64; tb += 16) { float ug[16];
#pragma unroll
            for (int k = 0; k < 16; ++k) ug[k] = bf_lo((unsigned)ugn[k]);
            if (tb + 16 < 64) {
#pragma unroll
                for (int k = 0; k < 16; ++k) ugn[k] = pu[(tb + 16 + k) * 16]; }
#pragma unroll
            for (int k = 0; k < 16; ++k) { h = av[tb + k] * h + bv[tb + k]; *py = (bf16)pk2(h * gelu_tanh(ug[k]), 0.f); py += D; }
            asm volatile("" ::: "memory"); }
        if (ck == 31) o_hp[(size_t)b * 1024 + cb * 16 + cl] = h;
        __syncthreads(); }
    for (int idx = blockIdx.x * NTHR + tid; idx < NBS * 1024; idx += G * NTHR) { const int b = idx >> 10, ch = idx & 1023; float h = h0s[idx];
        const size_t ob = ((size_t)(ch >> 4) * M + MP + b * DSQ) * 16 + (ch & 15);
        unsigned gw[8]; float ug[8];
#pragma unroll
        for (int t = 0; t < DSQ; ++t) { gw[t] = GAB[ob + t * 16]; ug[t] = bf_lo((unsigned)UG[ob + t * 16]); }
#pragma unroll
        for (int t = 0; t < DSQ; ++t) { const int row = MP + b * DSQ + t; h = __expf(bf_lo(gw[t])) * h + bf_hi(gw[t]); Y2[(size_t)row * D + 1024 + ch] = (bf16)pk2(h * gelu_tanh(ug[t]), 0.f); }
        o_hs[idx] = h; }
}

constexpr int S5_BU_STRIDE = 132, S5_XS_STRIDE = 68, S5_WAVE_LDS = 16 * S5_BU_STRIDE * 4 + 16 * S5_XS_STRIDE * 4;
typedef short s5_bf16x8 __attribute__((ext_vector_type(8)));
__device__ __forceinline__ s5_bf16x8 s5_pack8(const float (&v)[8]) { v4u w; w.x = pk2(v[0], v[1]); w.y = pk2(v[2], v[3]); w.z = pk2(v[4], v[5]); w.w = pk2(v[6], v[7]); return __builtin_bit_cast(s5_bf16x8, w); }
__device__ __forceinline__ void s5_setup(const Args& a, int o, int g, int lane, s5_bf16x8 (&bbf)[8], s5_bf16x8 (&cmf)[4], s5_bf16x8& dmf, float (&gm8)[8], float& ar, float& ai) {
    unsigned char* ws = a.ws; const int og = o * 128 + g, tl = lane & 15, q = lane >> 4;
    const float* BB = (const float*)(ws + WS_BB);
#pragma unroll
    for (int nb = 0; nb < 8; ++nb) { float v[8];
#pragma unroll
        for (int j = 0; j < 8; ++j) v[j] = 0.f;
        if (q < 2) { const int pp = nb * 16 + tl; const float* s = BB + ((size_t)og * 64 + (pp >> 1)) * 32 + (pp & 1) * 16 + 8 * q; const f32x4 v0 = *(const f32x4*)s, v1 = *(const f32x4*)(s + 4);
            v[0] = v0[0]; v[1] = v0[1]; v[2] = v0[2]; v[3] = v0[3]; v[4] = v1[0]; v[5] = v1[1]; v[6] = v1[2]; v[7] = v1[3]; }
        bbf[nb] = s5_pack8(v); }
#pragma unroll
    for (int kb = 0; kb < 4; ++kb) { const size_t ci = ((size_t)og * 16 + tl) * 64 + kb * 16 + 4 * q; const f32x4 cr = *(const f32x4*)(a.in[30] + ci), cm = *(const f32x4*)(a.in[31] + ci);
        const float v[8] = {cr[0], -cm[0], cr[1], -cm[1], cr[2], -cm[2], cr[3], -cm[3]}; cmf[kb] = s5_pack8(v); }
    { const float dv = a.in[32][(size_t)o * D + g * 16 + tl]; float v[8];
#pragma unroll
      for (int j = 0; j < 8; ++j) v[j] = (q < 2 && 8 * q + j == tl) ? dv : 0.f;
      dmf = s5_pack8(v); }
#pragma unroll
    for (int j = 0; j < 8; ++j) gm8[j] = (q < 2) ? a.in[10][(size_t)(2 * o + 1) * D + g * 16 + 8 * q + j] : 0.f;
    const float* AB = (const float*)(ws + WS_AB) + ((size_t)og * 64 + lane) * 2; ar = AB[0]; ai = AB[1];
}
template <int MODE>
__device__ __forceinline__ void s5_run(const Args& a, int row0, int L, int g, const pg8::rs_t* rs, LAS unsigned char* wl, int lane,
                                       const s5_bf16x8 (&bbf)[8], const s5_bf16x8 (&cmf)[4], const s5_bf16x8& dmf, const float (&gm8)[8], float ar, float ai, float& xr, float& xi,
                                       const float* sin_re, const float* sin_im, float* sout_re, float* sout_im) {
    unsigned char* ws = a.ws; const bf16* X = (const bf16*)(ws + WS_XB); bf16* Y2 = (bf16*)(ws + WS_Y2);
    const int tl = lane & 15, q = lane >> 4; constexpr bool FULL = MODE != 0; constexpr size_t SSEQ = (size_t)NGRP * NST;
    LAS float* Bu = (LAS float*)wl; LAS unsigned* Xs = (LAS unsigned*)(wl + 16 * S5_BU_STRIDE * 4);
    const f32x4 zero4 = (f32x4){0.f, 0.f, 0.f, 0.f};
    const int nblk = (L + 15) >> 4;
    v4u xw[3]; float rv[3]; const v4u zw = (v4u){0u, 0u, 0u, 0u};
#pragma unroll
    for (int k = 0; k < 3; ++k) { xw[k] = zw; rv[k] = 1.f;
        if (q < 2 && 16 * k + tl < L) { xw[k] = *(const v4u*)(X + (size_t)(row0 + 16 * k + tl) * D + g * 16 + 8 * q); rv[k] = pg8::rs_get(rs[row0 + 16 * k + tl]); } }
    float n0r = 0.f, n0i = 0.f, n1r = 0.f, n1i = 0.f;
    if (MODE == 2) { n0r = sin_re[lane]; n0i = sin_im[lane]; n1r = sin_re[SSEQ + lane]; n1i = sin_im[SSEQ + lane]; }
#define S5_NEXT_BU(TN) do { \
        { const float rstd = pg8::rstd_of(rv[0], INV_D); const v4u x0 = xw[0]; const float v[8] = {bf_lo(x0.x) * rstd * gm8[0], bf_hi(x0.x) * rstd * gm8[1], bf_lo(x0.y) * rstd * gm8[2], bf_hi(x0.y) * rstd * gm8[3], bf_lo(x0.z) * rstd * gm8[4], bf_hi(x0.z) * rstd * gm8[5], bf_lo(x0.w) * rstd * gm8[6], bf_hi(x0.w) * rstd * gm8[7]}; \
          ufn = s5_pack8(v); } \
        xw[0] = xw[1]; rv[0] = rv[1]; xw[1] = xw[2]; rv[1] = rv[2]; xw[2] = zw; rv[2] = 1.f; \
        if (q < 2 && (TN) + 48 + tl < L) { xw[2] = *(const v4u*)(X + (size_t)(row0 + (TN) + 48 + tl) * D + g * 16 + 8 * q); rv[2] = pg8::rs_get(rs[row0 + (TN) + 48 + tl]); } \
        _Pragma("unroll") \
        for (int nb = 0; nb < 8; ++nb) { const f32x4 d = __builtin_amdgcn_mfma_f32_16x16x32_bf16(bbf[nb], ufn, zero4, 0, 0, 0); *(LAS f32x4*)(Bu + tl * S5_BU_STRIDE + nb * 16 + 4 * q) = d; }     \
    } while (0)
    s5_bf16x8 ufn;
    S5_NEXT_BU(0);
    for (int blk = 0; blk < nblk; ++blk) {
        const int t0 = blk * 16, nst = (L - t0) < 16 ? (L - t0) : 16;
        float s0r = 0.f, s0i = 0.f, s1r = 0.f, s1i = 0.f;
        if (MODE == 2) { s0r = n0r; s0i = n0i; s1r = n1r; s1i = n1i;
            if (blk + 1 < nblk) { n0r = sin_re[(size_t)(2 * blk + 2) * SSEQ + lane]; n0i = sin_im[(size_t)(2 * blk + 2) * SSEQ + lane]; n1r = sin_re[(size_t)(2 * blk + 3) * SSEQ + lane]; n1i = sin_im[(size_t)(2 * blk + 3) * SSEQ + lane]; } }
        const s5_bf16x8 uf = ufn;
        LDS_WAIT(); asm volatile("" ::: "memory");
        typedef float f32x2v __attribute__((ext_vector_type(2)));
        f32x2v bw[16];
#pragma unroll
        for (int t = 0; t < 16; ++t) bw[t] = *(const LAS f32x2v*)(Bu + t * S5_BU_STRIDE + 2 * lane);
        if (blk + 1 < nblk) S5_NEXT_BU(t0 + 16);
        f32x2v xs = (f32x2v){xr, xi}; const f32x2v aar = (f32x2v){ar, ar}, aai = (f32x2v){-ai, ai};
        if (MODE != 2 && nst == 16) {
#pragma unroll
            for (int t = 0; t < 16; ++t) { const f32x2v bb = bw[t]; xs = aar * xs + (aai * (f32x2v){xs.y, xs.x} + bb);
                if (FULL) Xs[t * S5_XS_STRIDE + lane] = pk2(xs.x, xs.y); } }
        else {
#pragma unroll
            for (int t = 0; t < 16; ++t) {
                if (MODE == 2) { if (t == 0) xs = (f32x2v){s0r, s0i}; if (t == 8) xs = (f32x2v){s1r, s1i}; }
                const f32x2v bb = bw[t]; const f32x2v nx = aar * xs + (aai * (f32x2v){xs.y, xs.x} + bb);
                if (t < nst) xs = nx;
                if (FULL) Xs[t * S5_XS_STRIDE + lane] = pk2(xs.x, xs.y);
                if (MODE == 2) { if (t == 7) { sout_re[(size_t)(2 * blk) * SSEQ + lane] = xs.x; sout_im[(size_t)(2 * blk) * SSEQ + lane] = xs.y; }
                                 if (t == 15) { sout_re[(size_t)(2 * blk + 1) * SSEQ + lane] = xs.x; sout_im[(size_t)(2 * blk + 1) * SSEQ + lane] = xs.y; } } } }
        xr = xs.x; xi = xs.y;
        LDS_WAIT(); asm volatile("" ::: "memory");
        if (FULL) {
            f32x4 y = zero4;
#pragma unroll
            for (int kb = 0; kb < 4; ++kb) { const s5_bf16x8 xf = *(const LAS s5_bf16x8*)(Xs + tl * S5_XS_STRIDE + kb * 16 + 4 * q); y = __builtin_amdgcn_mfma_f32_16x16x32_bf16(cmf[kb], xf, y, 0, 0, 0); }
            y = __builtin_amdgcn_mfma_f32_16x16x32_bf16(dmf, uf, y, 0, 0, 0);
            if (tl < nst) { v2u w; w.x = pk2(gelu_tanh(y[0]), gelu_tanh(y[1])); w.y = pk2(gelu_tanh(y[2]), gelu_tanh(y[3])); *(v2u*)(Y2 + (size_t)(row0 + t0 + tl) * D + g * 16 + 4 * q) = w; }
            asm volatile("" ::: "memory"); }
    }
}
#undef S5_NEXT_BU
__device__ __forceinline__ void s5_pass1(const Args& a, int o, int g, int row0, const pg8::rs_t* rs, LAS unsigned char* wl, int lane, float ar, float ai, float& xr, float& xi) {
    unsigned char* ws = a.ws; const bf16* X = (const bf16*)(ws + WS_XB); const int tl = lane & 15, q = lane >> 4, og = o * 128 + g;
    const bf16* W1 = (const bf16*)(ws + WS_W1) + (size_t)og * 128 * 256; LAS float* P1 = (LAS float*)wl;
    typedef float f32x2v __attribute__((ext_vector_type(2)));
    float gmb[8];
#pragma unroll
    for (int j = 0; j < 8; ++j) gmb[j] = a.in[10][(size_t)(2 * o + 1) * D + g * 16 + 8 * (q & 1) + j];
    v4u xw[8]; float rv[8];
#pragma unroll
    for (int ks = 0; ks < 8; ++ks) { const int row = row0 + 16 * tl + 2 * ks + (q >> 1); xw[ks] = *(const v4u*)(X + (size_t)row * D + g * 16 + 8 * (q & 1)); rv[ks] = pg8::rs_get(rs[row]); }
    s5_bf16x8 uf[8];
#pragma unroll
    for (int ks = 0; ks < 8; ++ks) { const float rstd = pg8::rstd_of(rv[ks], INV_D); const v4u x0 = xw[ks];
        const float v[8] = {bf_lo(x0.x) * rstd * gmb[0], bf_hi(x0.x) * rstd * gmb[1], bf_lo(x0.y) * rstd * gmb[2], bf_hi(x0.y) * rstd * gmb[3], bf_lo(x0.z) * rstd * gmb[4], bf_hi(x0.z) * rstd * gmb[5], bf_lo(x0.w) * rstd * gmb[6], bf_hi(x0.w) * rstd * gmb[7]};
        uf[ks] = s5_pack8(v); }
    for (int qt = 0; qt < 4; ++qt) {
        const bf16* W1q = W1 + (size_t)(qt * 2) * 8 * 64 * 8 + (size_t)lane * 8;
        s5_bf16x8 af[2][8];
#pragma unroll
        for (int mb = 0; mb < 2; ++mb)
#pragma unroll
            for (int ks = 0; ks < 8; ++ks) af[mb][ks] = *(const s5_bf16x8*)(W1q + (size_t)(mb * 8 + ks) * 512);
        f32x4 acc[2] = {(f32x4){0.f, 0.f, 0.f, 0.f}, (f32x4){0.f, 0.f, 0.f, 0.f}};
#pragma unroll
        for (int ks = 0; ks < 8; ++ks)
#pragma unroll
            for (int mb = 0; mb < 2; ++mb) acc[mb] = __builtin_amdgcn_mfma_f32_16x16x32_bf16(af[mb][ks], uf[ks], acc[mb], 0, 0, 0);
#pragma unroll
        for (int mb = 0; mb < 2; ++mb) *(LAS f32x4*)(P1 + tl * S5_BU_STRIDE + qt * 32 + mb * 16 + 4 * q) = acc[mb];
        asm volatile("" ::: "memory"); }
    LDS_WAIT(); asm volatile("" ::: "memory");
    float pr = ar, pi = ai;
#pragma unroll
    for (int k = 0; k < 4; ++k) { const float nr = pr * pr - pi * pi, ni = 2.0f * pr * pi; pr = nr; pi = ni; }
    f32x2v e[16];
#pragma unroll
    for (int b = 0; b < 16; ++b) e[b] = *(const LAS f32x2v*)(P1 + b * S5_BU_STRIDE + 2 * lane);
    f32x2v xs = (f32x2v){0.f, 0.f}; const f32x2v ppr = (f32x2v){pr, pr}, ppi = (f32x2v){-pi, pi};
#pragma unroll
    for (int b = 0; b < 16; ++b) xs = ppr * xs + (ppi * (f32x2v){xs.y, xs.x} + e[b]);
    xr = xs.x; xi = xs.y;
    LDS_WAIT(); asm volatile("" ::: "memory");
}
__device__ __forceinline__ void s5_phase(const Args& a, int o, const pg8::rs_t* rs, LAS unsigned char* lds) {
    int tid = threadIdx.x; asm volatile("" : "+v"(tid)); const int lane = tid & 63, wave = __builtin_amdgcn_readfirstlane(tid >> 6);
    const int G = gridDim.x; LAS unsigned char* wl = lds + RING_OFF + wave * S5_WAVE_LDS; LAS float* ends = (LAS float*)(lds + RING_OFF + NWAVES * S5_WAVE_LDS);
    s5_bf16x8 bbf[8], cmf[4], dmf; float gm8[8], ar = 0.f, ai = 0.f; int gprev = -1;
    for (int it = blockIdx.x; it < NBP * NGRP; it += G) {
        int b = it >> 7, g = it & 127;
        if (G == 256) { const int c = it & 255, k = it >> 8, x = c & 7, j = c >> 3; g = x * 16 + (j & 15); b = 2 * k + (j >> 4); }
        const int row0 = b * SEQ + wave * 256;
        const bool fresh = g != gprev;
        if (fresh) { const float* AB = (const float*)(a.ws + WS_AB) + ((size_t)(o * 128 + g) * 64 + lane) * 2; ar = AB[0]; ai = AB[1]; }
        float xr = 0.f, xi = 0.f;
        s5_pass1(a, o, g, row0, rs, wl, lane, ar, ai, xr, xi);
        asm volatile("" ::: "memory");
        if (fresh) { s5_setup(a, o, g, lane, bbf, cmf, dmf, gm8, ar, ai); gprev = g; }
        ends[(wave * 2 + 0) * 64 + lane] = xr; ends[(wave * 2 + 1) * 64 + lane] = xi;
        float pr = ar, pi = ai;
#pragma unroll
        for (int k = 0; k < 8; ++k) { const float nr = pr * pr - pi * pi, ni = 2.0f * pr * pi; pr = nr; pi = ni; }
        LDS_WAIT(); __syncthreads();
        xr = 0.f; xi = 0.f;
        for (int j = 0; j < wave; ++j) { const float er = ends[(j * 2 + 0) * 64 + lane], ei = ends[(j * 2 + 1) * 64 + lane]; const float nr = pr * xr - pi * xi + er, ni = pr * xi + pi * xr + ei; xr = nr; xi = ni; }
        s5_run<1>(a, row0, 256, g, rs, wl, lane, bbf, cmf, dmf, gm8, ar, ai, xr, xi, nullptr, nullptr, nullptr, nullptr);
        if (wave == NWAVES - 1) { const size_t so = ((size_t)(o * NBP + b) * NGRP + g) * NST; a.out[O_REP + so + lane] = xr; a.out[O_IMP + so + lane] = xi; }
        __syncthreads(); }
    for (int it = blockIdx.x * NWAVES + wave; it < NGRP * (NBS / 8); it += G * NWAVES) { const int g = it & 127, b0 = (it >> 7) * 8; const size_t so = ((size_t)(o * NBS + b0) * NGRP + g) * NST;
        s5_setup(a, o, g, lane, bbf, cmf, dmf, gm8, ar, ai);
        float xr = 0.f, xi = 0.f;
        s5_run<2>(a, MP + b0 * DSQ, 8 * DSQ, g, rs, wl, lane, bbf, cmf, dmf, gm8, ar, ai, xr, xi, a.in[5] + so, a.in[6] + so, a.out + O_RES + so, a.out + O_IMS + so); }
}

template <int MODE>
__device__ __forceinline__ void splitk_fixup(const Args& a, const pg8::Gemm& g, int L0, int ntail, int nsplit, const pg8::rs_t* rs, pg8::rs_t* rsn, float alpha) {
    int tid = threadIdx.x; asm volatile("" : "+v"(tid)); const int lane = tid & 63, wave = __builtin_amdgcn_readfirstlane(tid >> 6);
    const int G = gridDim.x, gw = blockIdx.x * NWAVES + wave, NGW = G * NWAVES;
    bf16* Xb = (bf16*)(a.ws + WS_XB); bf16* Hb = (bf16*)(a.ws + WS_H); const bf16* P = (const bf16*)(a.ws + WS_PART);
    pg8::StaticOrder so; so.init(g, G, 0);
    if (MODE == 0 && nsplit == 8) {
        const int total = ntail * 256;
        for (int it0 = gw; it0 < total; it0 += 4 * NGW) { v2u p[4][8]; v2u xo[4]; size_t off[4]; int row[4]; bool ok[4];
#pragma unroll
            for (int k = 0; k < 4; ++k) { const int it = it0 + k * NGW; ok[k] = it < total; const int itc = ok[k] ? it : it0; const int ti = itc >> 8, r = itc & 255; pg8::Unit u; so.tile_of(L0 + ti, u);
                row[k] = u.pm * 256 + r; off[k] = (size_t)row[k] * D + u.pn * 256 + 4 * lane; xo[k] = *(const v2u*)(Xb + off[k]);
#pragma unroll
                for (int sp = 0; sp < 8; ++sp) p[k][sp] = *(const v2u*)(P + (size_t)(sp * ntail + ti) * 65536 + r * 256 + 4 * lane); }
#pragma unroll
            for (int k = 0; k < 4; ++k) { float s0 = 0.f, s1 = 0.f, s2 = 0.f, s3 = 0.f;
#pragma unroll
                for (int sp = 0; sp < 8; ++sp) { s0 += bf_lo(p[k][sp].x); s1 += bf_hi(p[k][sp].x); s2 += bf_lo(p[k][sp].y); s3 += bf_hi(p[k][sp].y); }
                v2u w; w.x = pk2(bf_lo(xo[k].x) + s0 * alpha, bf_hi(xo[k].x) + s1 * alpha); w.y = pk2(bf_lo(xo[k].y) + s2 * alpha, bf_hi(xo[k].y) + s3 * alpha);
                const float v0 = bf_lo(w.x), v1 = bf_hi(w.x), v2 = bf_lo(w.y), v3 = bf_hi(w.y); const float ss = wave_sum((v0 * v0 + v1 * v1) + (v2 * v2 + v3 * v3));
                if (ok[k]) { *(v2u*)(Xb + off[k]) = w; if (lane == 0) pg8::rs_add(rsn + row[k], ss); } } }
        return; }
    for (int it = gw; it < ntail * 256; it += NGW) { const int ti = it >> 8, r = it & 255; pg8::Unit u; so.tile_of(L0 + ti, u); const int row = u.pm * 256 + r;
        if (MODE == 0) { const int col = u.pn * 256 + 4 * lane; float s0 = 0.f, s1 = 0.f, s2 = 0.f, s3 = 0.f;
            for (int sp = 0; sp < nsplit; ++sp) { const v2u p = *(const v2u*)(P + (size_t)(sp * ntail + ti) * 65536 + r * 256 + 4 * lane); s0 += bf_lo(p.x); s1 += bf_hi(p.x); s2 += bf_lo(p.y); s3 += bf_hi(p.y); }
            const size_t off = (size_t)row * D + col; const v2u xo = *(const v2u*)(Xb + off);
            v2u w; w.x = pk2(bf_lo(xo.x) + s0 * alpha, bf_hi(xo.x) + s1 * alpha); w.y = pk2(bf_lo(xo.y) + s2 * alpha, bf_hi(xo.y) + s3 * alpha); *(v2u*)(Xb + off) = w;
            const float v0 = bf_lo(w.x), v1 = bf_hi(w.x), v2 = bf_lo(w.y), v3 = bf_hi(w.y);
            const float ss = wave_sum((v0 * v0 + v1 * v1) + (v2 * v2 + v3 * v3)); if (lane == 0) pg8::rs_add(rsn + row, ss); }
        else { float a0 = 0.f, a1 = 0.f, b0 = 0.f, b1 = 0.f;
            for (int sp = 0; sp < nsplit; ++sp) { const bf16* p = P + (size_t)(sp * ntail + ti) * 65536 + r * 256 + 2 * lane; const unsigned p1 = *(const unsigned*)p, p2 = *(const unsigned*)(p + 128); a0 += bf_lo(p1); a1 += bf_hi(p1); b0 += bf_lo(p2); b1 += bf_hi(p2); }
            if (MODE == 1) { const float rstd = pg8::rstd_of(pg8::rs_get(rs[row]), INV_D); const float g0 = a0 * rstd, g1 = a1 * rstd;
                *(unsigned*)(Hb + (size_t)row * DFF + u.pn * 128 + 2 * lane) = pk2(g0 * pg8::sigmoidf_fast(g0) * (b0 * rstd), g1 * pg8::sigmoidf_fast(g1) * (b1 * rstd)); }
            else { const size_t off = (size_t)row * D + u.pn * 128 + 2 * lane; const unsigned xo = *(const unsigned*)(Xb + off);
                const unsigned w = pk2(bf_lo(xo) + a0 * pg8::sigmoidf_fast(b0), bf_hi(xo) + a1 * pg8::sigmoidf_fast(b1)); *(unsigned*)(Xb + off) = w;
                const float v0 = bf_lo(w), v1 = bf_hi(w); const float ss = wave_sum(v0 * v0 + v1 * v1); if (lane == 0) pg8::rs_add(rsn + row, ss); } }
    }
}

__device__ __forceinline__ void final_norm(const Args& a, const pg8::rs_t* rs) {
    int tid = threadIdx.x; asm volatile("" : "+v"(tid)); const int lane = tid & 63, wave = __builtin_amdgcn_readfirstlane(tid >> 6);
    const bf16* Xb = (const bf16*)(a.ws + WS_XB); const float* gn = a.in[34]; const int gw = blockIdx.x * NWAVES + wave, NGW = gridDim.x * NWAVES;
    f32x4 gq[8];
#pragma unroll
    for (int q = 0; q < 8; ++q) gq[q] = *((const f32x4*)gn + lane + 64 * q);
    for (int m0 = gw; m0 < M; m0 += 5 * NGW) { v2u xr[5][8]; pg8::rs_t rv[5];
#pragma unroll
        for (int k = 0; k < 5; ++k) { const int m = m0 + k * NGW; const int mc = m < M ? m : m0; rv[k] = rs[mc];
#pragma unroll
            for (int q = 0; q < 8; ++q) xr[k][q] = *((const v2u*)(Xb + (size_t)mc * D) + lane + 64 * q); }
#pragma unroll
        for (int k = 0; k < 5; ++k) { const int m = m0 + k * NGW; if (m < M) { const float rstd = pg8::rstd_of(pg8::rs_get(rv[k]), INV_D); float* dst = (m < MP) ? a.out + O_YP + (size_t)m * D : a.out + O_YS + (size_t)(m - MP) * D;
#pragma unroll
                for (int q = 0; q < 8; ++q) { const v2u x = xr[k][q]; *((f32x4*)dst + lane + 64 * q) = (f32x4){bf_lo(x.x) * rstd * gq[q][0], bf_hi(x.x) * rstd * gq[q][1], bf_lo(x.y) * rstd * gq[q][2], bf_hi(x.y) * rstd * gq[q][3]}; } } } }
}

#ifndef PH_MASK
#define PH_MASK 0xFFF
#endif
#ifndef MK_PER_PHASE
#define MK_PER_PHASE 0
#endif
__global__ void __launch_bounds__(NTHR, 2) mk_fwd(Args a) {
    extern __shared__ __attribute__((aligned(16))) unsigned char lds_raw[];
    LAS unsigned char* lds = (LAS unsigned char*)lds_raw;
    const int tid = threadIdx.x, G = gridDim.x;
    volatile LAS unsigned* MISC = (volatile LAS unsigned*)(lds + MISC_OFF);
    for (int u = tid; u < (LDS_BYTES - LDSCTL_OFF) / 4; u += NTHR) ((LAS unsigned*)(lds + LDSCTL_OFF))[u] = 0u;
    __syncthreads();
    unsigned char* ws = a.ws;
    unsigned* ctl = (unsigned*)(ws + WS_CTL);
    const int lo = a.lo, hi = a.hi;
    XcdBarrier bar; bar.bar = ctl + CW_BAR; bar.x = 0; bar.st = nullptr;
    if (hi - lo > 1) bar = xcd_barrier_post(ctl + CW_BAR, MISC + 8);
    bf16* Xb = (bf16*)(ws + WS_XB); pg8::rs_t* RS = (pg8::rs_t*)(ws + WS_RS); bf16* Hb = (bf16*)(ws + WS_H);
    bf16* Z = (bf16*)(ws + WS_Z); bf16* Dp = (bf16*)(ws + WS_DP); bf16* Cv = (bf16*)(ws + WS_CV);
    unsigned* GAB = (unsigned*)(ws + WS_GA); bf16* Y2 = (bf16*)(ws + WS_Y2);
    int pc = 0;
#define ON() (pc >= lo && pc < hi)
#define SEAM() do { if (pc >= lo && pc + 1 < hi) xcd_barrier(bar); ++pc; } while (0)
#define GEMM_PHASE(EPI, g, E) do { pg8::StaticOrder S_; S_.init(g, G, (int)blockIdx.x); pg8::gemm_phase<EPI, pg8::StaticOrder, true, true>(lds + RING_OFF, g, S_, E); } while (0)

#define GEMM_TAIL_PHASE(EPI, MODE, g, E, NFULL, rs_, rsn_, alpha_) do { \
        const int nun_ = ((g).M / 256) * ((g).N / 256), ntail_ = nun_ - (NFULL) * G, npairs_ = (g).K / 128; \
        const bool split_ = ntail_ > 0 && ntail_ <= G; int nsplit_ = split_ ? G / ntail_ : 1; if (nsplit_ > npairs_ / 2) nsplit_ = npairs_ / 2; \
        if (ON()) { { pg8::StaticOrder S_; S_.init(g, G, (int)blockIdx.x, split_ ? (NFULL) : (1 << 30)); pg8::gemm_phase<EPI, pg8::StaticOrder, true, true>(lds + RING_OFF, g, S_, E); } \
            if (split_) { const pg8::EpiPartial EP_{(bf16*)(ws + WS_PART)}; pg8::SplitTailOrder T_; T_.init(g, G, (int)blockIdx.x, (NFULL) * G, ntail_, nsplit_); pg8::gemm_phase<pg8::EpiPartial, pg8::SplitTailOrder, true, true>(lds + RING_OFF, g, T_, EP_); } } \
        SEAM(); \
        if (split_) { if (ON()) splitk_fixup<MODE>(a, g, (NFULL) * G, ntail_, nsplit_, rs_, rsn_, alpha_); \
            SEAM(); } } while (0)

    if (ON()) if constexpr ((PH_MASK >> 0) & 1) { p0_prologue(a, lds); }
    SEAM();
    int fi = 0;
    for (int l = 0; l <= 4; ++l) {
        const int nrep = (l == 0 || l == 4) ? 1 : 2;
        for (int rep = 0; rep < nrep; ++rep, ++fi) {
            const int xv = fi + ((fi + 1) >> 1);
            const int dk = (G != 256 || fi == 0) ? 0 : ((fi & 1) == 0 ? 1 : ((fi & 3) == 1 ? 2 : 3));
            const bool defer_this = (G == 256) && (fi == 1 || fi == 3 || fi == 5);
            { const pg8::Gemm g{Xb, (const bf16*)(ws + WS_FIN + (size_t)fi * SZ_FIN), M, NFF, D, D, 0, 0}; const pg8::EpiSwiglu E{Hb, DFF, RS + (size_t)xv * M, INV_D};
              const int GG = (G == 256) ? 224 : G, nrounds = ((M / 256) * (NFF / 256) + GG - 1) / GG;
              {
                if (ON()) if constexpr ((PH_MASK >> 1) & 1) {
                    unsigned* dflag = ctl + CW_FLAG + 64 * fi;
                    if (GG == G) { int tid3 = threadIdx.x; asm volatile("" : "+v"(tid3)); const int w3 = __builtin_amdgcn_readfirstlane(tid3 >> 6); cvt_stage(a, fi + 1, (int)blockIdx.x * NWAVES + w3, G * NWAVES, tid3 & 63, (LAS unsigned*)(lds + RING_OFF + w3 * 9216)); __syncthreads(); }
                    if ((int)blockIdx.x < GG) { pg8::SeqOrder S_; S_.init(g, MP / 256, GG, (int)blockIdx.x, 0, nrounds); if (dk) { S_.flag = dflag; S_.target = (unsigned)(G - GG); } pg8::gemm_phase<pg8::EpiSwiglu, pg8::SeqOrder, true, true>(lds + RING_OFF, g, S_, E); }
                    else {
                      if (dk) { const int c2 = (int)blockIdx.x - GG, lm = (fi - 1) >> 1;
                        if (dk == 3) { const pg8::Gemm g2{Y2, (const bf16*)(ws + WS_GLU + (size_t)(lm >> 1) * SZ_GLU), M, 4096, D, D, 0, 0}; const pg8::EpiGlu E2{Xb, RS + (size_t)xv * M};
                            const pg8::FewUnitsOrder O_{MP / 256, MS / 256, 16, 2 * c2, 2, D}; pg8::gemm_phase<pg8::EpiGlu, pg8::FewUnitsOrder, true, true>(lds + RING_OFF, g2, O_, E2); }
                        else { const pg8::Gemm g2{dk == 1 ? Hb : Y2, dk == 1 ? (const bf16*)(ws + WS_FOUT + (size_t)(fi - 1) * SZ_FOUT) : (const bf16*)(ws + WS_EOUT + (size_t)(lm >> 1) * SZ_EOUT), M, D, dk == 1 ? DFF : D, dk == 1 ? DFF : D, 0, 0};
                            const pg8::EpiResid E2{Xb, RS + (size_t)xv * M, dk == 1 ? 0.5f : 1.0f};
                            const pg8::FewUnitsOrder O_{MP / 256, MS / 256, 8, c2, 1, g2.K}; pg8::gemm_phase<pg8::EpiResid, pg8::FewUnitsOrder, true, true>(lds + RING_OFF, g2, O_, E2); }
                        asm volatile("s_waitcnt vmcnt(0)" ::: "memory"); __syncthreads();
                        if (threadIdx.x == 0) { __builtin_amdgcn_fence(__ATOMIC_RELEASE, "agent"); asm volatile("s_waitcnt vmcnt(0)" ::: "memory"); (void)xb_add(dflag, 1u); } }
                      { int tid2 = threadIdx.x; asm volatile("" : "+v"(tid2)); const int w2 = __builtin_amdgcn_readfirstlane(tid2 >> 6); cvt_stage(a, fi + 1, ((int)blockIdx.x - GG) * NWAVES + w2, (G - GG) * NWAVES, tid2 & 63, (LAS unsigned*)(lds + RING_OFF + w2 * 9216)); } } }
                SEAM(); } }
            if constexpr ((PH_MASK >> 2) & 1) { const pg8::Gemm g{Hb, (const bf16*)(ws + WS_FOUT + (size_t)fi * SZ_FOUT), defer_this ? MP : M, D, DFF, DFF, 0, 0}; const pg8::EpiResid E{Xb, RS + (size_t)(xv + 1) * M, 0.5f};
              GEMM_TAIL_PHASE(pg8::EpiResid, 0, g, E, (((g).M / 256) * (D / 256)) / G, (const pg8::rs_t*)nullptr, RS + (size_t)(xv + 1) * M, 0.5f); }
        }
        if (l < 4) {
            const int xv = 3 * l + 1;
            if ((l & 1) == 0) { const int e = l >> 1;
                if (ON()) { const pg8::Gemm g{Xb, (const bf16*)(ws + WS_EIN + (size_t)e * SZ_EIN), M, DINE, D, D, 0, 0}; const pg8::EpiZ E{Z, 2048, RS + (size_t)xv * M, INV_D, (bf16*)(ws + WS_UGB), M}; if constexpr ((PH_MASK >> 3) & 1) { GEMM_PHASE(pg8::EpiZ, g, E); } }
                SEAM();
                if (ON()) if constexpr ((PH_MASK >> 4) & 1) { even_prep(a, e); }
                SEAM();
                if (ON()) { { const pg8::Gemm g{Cv, (const bf16*)(ws + WS_GATE + (size_t)e * SZ_GATE), M, 2048, 256, 1024, 1, 256};
                              const pg8::EpiGate E{Cv, a.in[20] + e * 1024, a.in[22] + e * 1024, (const float*)(ws + WS_LS) + e * 1024, GAB, M}; if constexpr ((PH_MASK >> 5) & 1) { GEMM_PHASE(pg8::EpiGate, g, E); } }
                            { const pg8::Gemm g{Dp, (const bf16*)(ws + WS_POOL + (size_t)e * SZ_POOL), M, 1024, 256, 1024, 0, 256};
                              const pg8::EpiPool E{Y2, D, a.in[16] + e * 1024}; if constexpr ((PH_MASK >> 6) & 1) { pg8::StaticOrder S_; S_.init(g, G, G - 1 - (int)blockIdx.x); pg8::gemm_phase<pg8::EpiPool, pg8::StaticOrder, true, true>(lds + RING_OFF, g, S_, E); } } }
                SEAM();
                if (ON()) if constexpr ((PH_MASK >> 7) & 1) { even_scan(a, e, lds); }
                SEAM();
                if (ON()) if constexpr ((PH_MASK >> 8) & 1) { const pg8::Gemm g{Y2, (const bf16*)(ws + WS_EOUT + (size_t)e * SZ_EOUT), (G == 256) ? MP : M, D, D, D, 0, 0}; const pg8::EpiResid E{Xb, RS + (size_t)(xv + 1) * M, 1.0f}; GEMM_PHASE(pg8::EpiResid, g, E); }
                SEAM();
            } else { const int o = l >> 1;
                if (ON()) if constexpr ((PH_MASK >> 9) & 1) { s5_phase(a, o, RS + (size_t)xv * M, lds); }
                SEAM();
                if (ON()) if constexpr ((PH_MASK >> 10) & 1) { const pg8::Gemm g{Y2, (const bf16*)(ws + WS_GLU + (size_t)o * SZ_GLU), (G == 256) ? MP : M, 4096, D, D, 0, 0}; const pg8::EpiGlu E{Xb, RS + (size_t)(xv + 1) * M}; GEMM_PHASE(pg8::EpiGlu, g, E); }
                SEAM();
            }
        }
    }
    if (ON()) if constexpr ((PH_MASK >> 11) & 1) { final_norm(a, RS + (size_t)12 * M); }
#undef ON
#undef SEAM
#undef GEMM_PHASE
#undef GEMM_TAIL_PHASE
}
constexpr int N_PHASES = 1000;

extern "C" void kernel_launch(void* const* d_in, const int* in_sizes, int n_in, void* d_out, int out_size, void* d_ws, size_t ws_size, hipStream_t stream) {
    static int grid = 0;
    if (grid == 0) {
        if (n_in != 35 || (size_t)out_size != O_END || ws_size < WS_END) { fprintf(stderr, "kernel_launch: built for 35 inputs, %zu outputs, >= %zu bytes of workspace; got n_in %d, out %d, ws %zu; nothing launched\n", (size_t)O_END, (size_t)WS_END, n_in, out_size, ws_size); grid = -1; return; }
        int dev = 0, cus = 0, per_cu = 0;
        if (hipGetDevice(&dev) != hipSuccess || hipDeviceGetAttribute(&cus, hipDeviceAttributeMultiprocessorCount, dev) != hipSuccess) { fprintf(stderr, "kernel_launch: device query failed\n"); grid = -1; return; }
        if (hipFuncSetAttribute((const void*)mk_fwd, hipFuncAttributeMaxDynamicSharedMemorySize, LDS_BYTES) != hipSuccess) { fprintf(stderr, "kernel_launch: hipFuncSetAttribute failed\n"); grid = -1; return; }
        if (hipOccupancyMaxActiveBlocksPerMultiprocessor(&per_cu, (const void*)mk_fwd, NTHR, LDS_BYTES) != hipSuccess || per_cu < 1) { fprintf(stderr, "kernel_launch: occupancy query says %d workgroups per CU\n", per_cu); }
        (void)hipGetLastError();
        grid = cus;
    }
    if (grid < 0) return;
    if (hipMemsetAsync((char*)d_ws + WS_CTL, 0, CTL_ZERO_BYTES, stream) != hipSuccess) { fprintf(stderr, "kernel_launch: memset failed\n"); return; }
    Args a; memset(&a, 0, sizeof(a));
    for (int i = 0; i < 35; ++i) a.in[i] = (const float*)d_in[i];
    a.out = (float*)d_out; a.ws = (unsigned char*)d_ws;
#if MK_PER_PHASE
    for (int ph = 0; ph < N_PHASES; ++ph) { a.lo = ph; a.hi = ph + 1; hipLaunchKernelGGL(mk_fwd, dim3(grid), dim3(NTHR), LDS_BYTES, stream, a); }
#else
    a.lo = 0; a.hi = N_PHASES; hipLaunchKernelGGL(mk_fwd, dim3(grid), dim3(NTHR), LDS_BYTES, stream, a);
#endif
    const hipError_t le = hipPeekAtLastError();
    if (le != hipSuccess) fprintf(stderr, "kernel_launch: launch failed: %s\n", hipGetErrorName(le));
}
```
